# Optimizing an MI355X kernel written in HIP

```python
import jax, jax.numpy as jnp
from jax import lax
import numpy as np

D_MODEL = 1024
BATCH = 2
SEQ = 8192
DEPTH = 1

SB_HEADS = 8
SB_HEAD_DIM = D_MODEL // SB_HEADS
SB_WIDTH = SB_HEADS * SB_HEAD_DIM
SB_BLOCK = 128
HG_HEADS = 8
HG_KEY_DIM = 128
HG_VAL_DIM = D_MODEL // HG_HEADS
HG_KEY_WIDTH = HG_HEADS * HG_KEY_DIM
HG_VAL_WIDTH = HG_HEADS * HG_VAL_DIM
HG_CHUNK = 64
N_BRANCHES = 2
RMS_EPS = 1e-6
IN_WIDTHS = (SB_WIDTH, SB_WIDTH, SB_WIDTH, SB_WIDTH,
             HG_KEY_WIDTH, HG_KEY_WIDTH, HG_VAL_WIDTH, HG_VAL_WIDTH,
             N_BRANCHES * D_MODEL)
IN_WIDTH = sum(IN_WIDTHS)

kernel_name = "hybrid_stickbreak_hgrn2_gated"


def rmsnorm(x, g):
    xf = x.astype(jnp.float32)
    y = xf * lax.rsqrt(jnp.mean(xf * xf, axis=-1, keepdims=True) + RMS_EPS)
    return (y * g.astype(jnp.float32)).astype(x.dtype)


def sb_attention(q, k, v):
    b, h, s, d = q.shape
    n_blocks = s // SB_BLOCK
    scale = d ** -0.5
    kf = k.astype(jnp.float32)
    vf = v.astype(jnp.float32)
    key_pos = jnp.arange(s)

    def block(i):
        start = i * SB_BLOCK
        qb = lax.dynamic_slice_in_dim(q, start, SB_BLOCK, axis=2).astype(jnp.float32)
        z = jnp.einsum('bhqd,bhkd->bhqk', qb, kf) * scale
        q_pos = start + jnp.arange(SB_BLOCK)
        causal = key_pos[None, :] < q_pos[:, None]
        log_not = jnp.where(causal, jax.nn.log_sigmoid(-z), 0.0)
        survive = lax.cumsum(log_not, axis=3, reverse=True) - log_not
        log_w = jnp.where(causal, jax.nn.log_sigmoid(z) + survive, -jnp.inf)
        w = jnp.exp(log_w)
        return jnp.einsum('bhqk,bhkd->bhqd', w, vf)

    out = lax.map(block, jnp.arange(n_blocks))
    out = jnp.transpose(out, (1, 2, 0, 3, 4)).reshape(b, h, s, d)
    return out.astype(q.dtype)


def hgrn2_chunked(q, k, g, v):
    b, s, h, dk = q.shape
    dv = v.shape[-1]
    n = s // HG_CHUNK

    def to_chunks(t):
        return t.reshape(b, n, HG_CHUNK, h, t.shape[-1]).transpose(1, 0, 3, 2, 4)

    causal = jnp.tril(jnp.ones((HG_CHUNK, HG_CHUNK), dtype=bool))[:, :, None]

    def step(state, inp):
        qc, kc, gc, vc = inp
        cum = jnp.cumsum(gc, axis=2)
        rel = cum[:, :, :, None, :] - cum[:, :, None, :, :]
        decay = jnp.exp(jnp.where(causal, rel, -jnp.inf))
        scores = jnp.einsum('bhtk,bhtsk,bhsk->bhts', qc, decay, kc)
        o = (jnp.einsum('bhts,bhsv->bhtv', scores, vc)
             + jnp.einsum('bhtk,bhkv->bhtv', qc * jnp.exp(cum), state))
        last = cum[:, :, -1:, :]
        state = (jnp.exp(last[:, :, 0, :])[..., None] * state
                 + jnp.einsum('bhsk,bhsv->bhkv', kc * jnp.exp(last - cum), vc))
        return state, o

    state0 = jnp.zeros((b, h, dk, dv), jnp.float32)
    _, o = lax.scan(step, state0, (to_chunks(q), to_chunks(k), to_chunks(g), to_chunks(v)))
    return o.transpose(1, 0, 3, 2, 4).reshape(b, s, h, dv)


def hybrid_layer(x, norm_g, w_in, b_gate, lb, hg_norm_g, w_sb_proj, w_hg_proj, w_out):
    b, s, _ = x.shape
    h = rmsnorm(x, norm_g)
    proj = jnp.einsum('bsd,de->bse', h, w_in)
    split_points = tuple(int(p) for p in np.cumsum(IN_WIDTHS)[:-1])
    sb_q, sb_k, sb_v, sb_z, hg_q, hg_f, hg_i, hg_z, gate_logits = jnp.split(proj, split_points, axis=-1)

    def heads(t):
        return t.reshape(b, s, SB_HEADS, SB_HEAD_DIM).transpose(0, 2, 1, 3)
    sb_o = sb_attention(heads(sb_q), heads(sb_k), heads(sb_v))
    sb_o = sb_o.transpose(0, 2, 1, 3).reshape(b, s, SB_WIDTH)
    u_sb = jnp.einsum('bse,ed->bsd', sb_o * jax.nn.silu(sb_z), w_sb_proj)

    f_logit = hg_f.reshape(b, s, HG_HEADS, HG_KEY_DIM).astype(jnp.float32)
    f = lb + (1.0 - lb) * jax.nn.sigmoid(f_logit)
    g = jnp.log(f)
    kk = 1.0 - f
    qq = jax.nn.silu(hg_q.reshape(b, s, HG_HEADS, HG_KEY_DIM).astype(jnp.float32))
    vv = hg_i.reshape(b, s, HG_HEADS, HG_VAL_DIM).astype(jnp.float32)
    hg_o = hgrn2_chunked(qq, kk, g, vv)
    hg_o = rmsnorm(hg_o, hg_norm_g).reshape(b, s, HG_VAL_WIDTH).astype(x.dtype)
    u_hg = jnp.einsum('bse,ed->bsd', hg_o * jax.nn.silu(hg_z), w_hg_proj)

    gates = jax.nn.sigmoid((gate_logits + b_gate).astype(jnp.float32)).astype(x.dtype)
    gate_sb, gate_hg = jnp.split(gates, N_BRANCHES, axis=-1)
    y = gate_sb * u_sb + gate_hg * u_hg
    return x + jnp.einsum('bsd,de->bse', y, w_out)


def setup_inputs(seed: int = 0) -> dict:
    key = jax.random.key(seed)
    ks = jax.random.split(key, 11)
    f32 = jnp.float32
    x = jax.random.normal(ks[0], (BATCH, SEQ, D_MODEL), f32)
    norm_g = 1.0 + 0.02 * jax.random.normal(ks[1], (DEPTH, D_MODEL), f32)
    w_in = jax.random.normal(ks[2], (DEPTH, D_MODEL, IN_WIDTH), f32) * D_MODEL ** -0.5
    b_gate = 0.1 * jax.random.normal(ks[3], (DEPTH, N_BRANCHES * D_MODEL), f32)
    lb_logits = 0.5 * jax.random.normal(ks[4], (DEPTH + 1, HG_HEADS, HG_KEY_DIM), f32)
    hg_norm_g = 1.0 + 0.02 * jax.random.normal(ks[5], (DEPTH, HG_HEADS, HG_VAL_DIM), f32)
    w_sb_proj = jax.random.normal(ks[6], (DEPTH, SB_WIDTH, D_MODEL), f32) * SB_WIDTH ** -0.5
    w_hg_proj = jax.random.normal(ks[7], (DEPTH, HG_VAL_WIDTH, D_MODEL), f32) * HG_VAL_WIDTH ** -0.5
    w_out = jax.random.normal(ks[8], (DEPTH, D_MODEL, D_MODEL), f32) * D_MODEL ** -0.5
    final_norm_g = 1.0 + 0.02 * jax.random.normal(ks[9], (D_MODEL,), f32)
    return {"x": x, "norm_g": norm_g, "w_in": w_in, "b_gate": b_gate, "lb_logits": lb_logits,
            "hg_norm_g": hg_norm_g, "w_sb_proj": w_sb_proj, "w_hg_proj": w_hg_proj,
            "w_out": w_out, "final_norm_g": final_norm_g}


def reference(x, norm_g, w_in, b_gate, lb_logits, hg_norm_g, w_sb_proj, w_hg_proj, w_out, final_norm_g):
    lb_all = jnp.cumsum(jax.nn.softmax(lb_logits.astype(jnp.float32), axis=0), axis=0)
    for l in range(DEPTH):
        x = hybrid_layer(x, norm_g[l], w_in[l], b_gate[l], lb_all[l], hg_norm_g[l],
                         w_sb_proj[l], w_hg_proj[l], w_out[l])
    return rmsnorm(x, final_norm_g)
```

```cpp
#include <hip/hip_runtime.h>
#include <hip/hip_cooperative_groups.h>
#include <cstdio>
#include <cstdint>
namespace cg = cooperative_groups;

#define LAS __attribute__((address_space(3)))
typedef unsigned short bf16_t;
typedef short bf16x8 __attribute__((ext_vector_type(8)));
typedef float f32x4 __attribute__((ext_vector_type(4)));
typedef unsigned u32x4 __attribute__((ext_vector_type(4)));
typedef unsigned u32x2 __attribute__((ext_vector_type(2)));

namespace pg8 {
constexpr int BM = 256, BK = 64, HALF = 128, HTB = HALF * BK * 2, STAGE_BYTES = 8 * HTB, NXCD = 8, WGM = 8;
__host__ __device__ __forceinline__ int lds_byte(int r, int c) { const int st = (r >> 4) * 2 + (c >> 5), rr = r & 15, cc = c & 31, ob = rr * 64 + cc * 2; return st * 1024 + (ob ^ (((ob >> 9) & 1) << 5)); }
__host__ __device__ __forceinline__ void stage_rc(int b, int& R, int& C) { const int st = b / 1024, sb = b % 1024, swz = sb ^ (((sb >> 9) & 1) << 5); R = (st >> 1) * 16 + swz / 64; C = (st & 1) * 32 + (swz % 64) / 2; }
__host__ __device__ __forceinline__ int perm32(int rho) { const int n = rho >> 4, i = rho & 15; return 8 * (i >> 2) + 4 * n + (i & 3); }

struct Unit { int pm, pn; };
struct Gemm { const bf16_t* A; const bf16_t* Bt; int M, N, K; };

struct StaticOrder {
    int nM, nN, nwg, G, c;
    __host__ __device__ void init(int M, int N, int G_, int c_) { nM = M / BM; nN = N / BM; nwg = nM * nN; G = G_; c = c_; }
    __host__ __device__ bool next(int i, Unit& u) const {
        const long L = (long)i * G + c; if (L >= nwg) return false;
        int wgid = (int)L; { const int q = nwg / NXCD, r = nwg % NXCD, xcd = wgid % NXCD, off = wgid / NXCD; wgid = (xcd < r ? xcd * (q + 1) : r * (q + 1) + (xcd - r) * q) + off; }
        const int nig = WGM * nN, gid = wgid / nig, fm = gid * WGM, gsz = (nM - fm) < WGM ? (nM - fm) : WGM;
        u.pm = fm + ((wgid % nig) % gsz); u.pn = (wgid % nig) / gsz; return true;
    }
};
struct SegOrder {
    StaticOrder so; int mode;
    __device__ void init(int G, int c, int mode_) { mode = mode_; so.init(16384, (mode_ == 0 ? 24 : 16) * 256, G, c); }
    __device__ bool next(int i, Unit& u) const {
        if (!so.next(i, u)) return false;
        if (mode == 0) u.pn = (u.pn < 12) ? u.pn : u.pn + 4; else u.pn = (u.pn < 4) ? u.pn + 12 : u.pn + 24;
        return true;
    }
    __device__ __forceinline__ void a_ready(const Unit&) const {}
    __device__ __forceinline__ void done(const Unit&) const {}
};
struct PairOrder {
    StaticOrder so;
    __device__ void init(int G, int c) { so.init(16384, 1024, G, c); }
    __device__ bool next(int i, Unit& u) const { if (!so.next(i >> 1, u)) return false; u.pm += 64 * (i & 1); u.pn += 4 * (i & 1); return true; }
    __device__ __forceinline__ void a_ready(const Unit&) const {}
    __device__ __forceinline__ void done(const Unit&) const {}
};
struct PlainOrder {
    StaticOrder so;
    __device__ void init(int M, int N, int G, int c) { so.init(M, N, G, c); }
    __device__ bool next(int i, Unit& u) const { return so.next(i, u); }
    __device__ __forceinline__ void a_ready(const Unit&) const {}
    __device__ __forceinline__ void done(const Unit&) const {}
};

typedef float f32x2_t __attribute__((ext_vector_type(2)));
typedef __bf16 bf16x2_t __attribute__((ext_vector_type(2)));
__device__ __forceinline__ unsigned cvt_pk_bf16(float lo, float hi) { f32x2_t v = {lo, hi}; bf16x2_t b = __builtin_convertvector(v, bf16x2_t); return __builtin_bit_cast(unsigned, b); }

template <class Epi, class Sched, bool ALIGN_EPI = false, bool SP2 = false>
__device__ __forceinline__ void gemm_phase(LAS unsigned char* lds, const Gemm g, const Sched& S, const Epi& E) {
    const int tid = threadIdx.x, wid = __builtin_amdgcn_readfirstlane(tid >> 6), lane = tid & 63, wr = wid >> 2, wc = wid & 3, fr = lane & 15, fq = lane >> 4;
    const int K = g.K, nt = K / BK;
    unsigned voffA[2], voffB[2];
#pragma unroll
    for (int i = 0; i < 2; ++i) { int R, C; stage_rc(tid * 16 + i * 8192, R, C); const int Rb = Epi::PERM ? ((R & ~31) + perm32(R & 31)) : R;
        voffA[i] = (unsigned)(R * K + C) * 2u; voffB[i] = (unsigned)(Rb * K + C) * 2u; }
    const size_t kstep = (size_t)(BK * 2);
    const size_t hstep = (size_t)HALF * K * 2;
    const size_t tstep = 2 * hstep;
    const unsigned ldsw = (unsigned)wid * 1024u;
    const int aoff = lds_byte(wr * 64 + fr, fq * 8), boff = lds_byte(wc * 32 + fr, fq * 8);
#define PG8_SA(b, h) (((b) * 2 + (h)) * HTB)
#define PG8_SB(b, h) ((4 + (b) * 2 + (h)) * HTB)
#define PG8_STAGE(bufoff, gbase, voff) do { _Pragma("unroll") for (int _i = 0; _i < 2; ++_i) \
        __builtin_amdgcn_global_load_lds((const unsigned*)((const char*)(gbase) + (voff)[_i]), (LAS unsigned*)(lds + (bufoff) + ldsw + _i * 8192), 16, 0, 0); } while (0)
#define PG8_LDA(dst, b, h) do { _Pragma("unroll") for (int m = 0; m < 4; ++m) _Pragma("unroll") for (int k = 0; k < 2; ++k) dst[m][k] = *(const LAS bf16x8*)(lds + PG8_SA(b, h) + aoff + m * 2048 + k * 1024); } while (0)
#define PG8_LDB(dst, b, h) do { _Pragma("unroll") for (int n = 0; n < 2; ++n) _Pragma("unroll") for (int k = 0; k < 2; ++k) dst[n][k] = *(const LAS bf16x8*)(lds + PG8_SB(b, h) + boff + n * 2048 + k * 1024); } while (0)
#define PG8_MMA(ai, bj, At, Bt) do { __builtin_amdgcn_s_setprio(1); _Pragma("unroll") for (int m = 0; m < 4; ++m) _Pragma("unroll") for (int n = 0; n < 2; ++n) _Pragma("unroll") for (int k = 0; k < 2; ++k) \
        acc[ai][bj][m][n] = __builtin_amdgcn_mfma_f32_16x16x32_bf16(Bt[n][k], At[m][k], acc[ai][bj][m][n], 0, 0, 0); __builtin_amdgcn_s_setprio(0); } while (0)
#define PG8_WAIT_V(n) asm volatile("s_waitcnt vmcnt(" #n ")" ::: "memory")
#define PG8_WAIT_L(n) asm volatile("s_waitcnt lgkmcnt(" #n ")" ::: "memory")
#define PG8_BAR __builtin_amdgcn_s_barrier()
#define PG8_SCHED __builtin_amdgcn_sched_barrier(0)
    Unit cur, nxt; int ui = 0;
    if (!S.next(0, cur)) return;
    f32x4 acc[2][2][4][2];
#pragma unroll
    for (int a = 0; a < 2; ++a)
#pragma unroll
        for (int b = 0; b < 2; ++b)
#pragma unroll
            for (int m = 0; m < 4; ++m)
#pragma unroll
                for (int n = 0; n < 2; ++n) acc[a][b][m][n] = (f32x4){0.f, 0.f, 0.f, 0.f};
    bf16x8 At[4][2], B0[2][2], B1[2][2];
    const char* cA = (const char*)g.A + (size_t)cur.pm * tstep; const char* cB = (const char*)g.Bt + (size_t)cur.pn * tstep;
    S.a_ready(cur);
    if constexpr (SP2) {
        PG8_STAGE(PG8_SB(0, 0), cB, voffB); PG8_STAGE(PG8_SB(0, 1), cB + hstep, voffB); PG8_STAGE(PG8_SA(0, 0), cA, voffA); PG8_STAGE(PG8_SA(0, 1), cA + hstep, voffA);
        if (wr == 1) PG8_BAR;
        PG8_WAIT_V(2); PG8_BAR;
        PG8_STAGE(PG8_SB(1, 0), cB + kstep, voffB); PG8_STAGE(PG8_SA(1, 0), cA + kstep, voffA); PG8_STAGE(PG8_SB(1, 1), cB + hstep + kstep, voffB);
        PG8_WAIT_V(6); PG8_BAR;
    } else {
        PG8_STAGE(PG8_SB(0, 0), cB, voffB); PG8_STAGE(PG8_SA(0, 0), cA, voffA); PG8_STAGE(PG8_SB(0, 1), cB + hstep, voffB); PG8_STAGE(PG8_SA(0, 1), cA + hstep, voffA);
        if (wr == 1) PG8_BAR;
        PG8_WAIT_V(4); PG8_BAR;
        PG8_STAGE(PG8_SB(1, 0), cB + kstep, voffB); PG8_STAGE(PG8_SA(1, 0), cA + kstep, voffA); PG8_STAGE(PG8_SB(1, 1), cB + hstep + kstep, voffB);
        PG8_WAIT_V(6); PG8_BAR;
    }
    for (;;) {
        const bool has_next = S.next(ui + 1, nxt);
        const char* nA = has_next ? (const char*)g.A + (size_t)nxt.pm * tstep : cA; const char* nB = has_next ? (const char*)g.Bt + (size_t)nxt.pn * tstep : cB;
        for (int t = 0; t < nt; t += 2) {
            const bool last = (t == nt - 2);
            const char* a1 = cA + (size_t)(t + 1) * kstep;
            const char* a2 = last ? nA : cA + (size_t)(t + 2) * kstep; const char* b2 = last ? nB : cB + (size_t)(t + 2) * kstep;
            const char* a3 = a2 + kstep; const char* b3 = b2 + kstep;
            if (last && has_next) S.a_ready(nxt);
            if constexpr (SP2) {
            PG8_LDB(B0, 0, 0); PG8_LDB(B1, 0, 1); PG8_SCHED; PG8_LDA(At, 0, 0); PG8_STAGE(PG8_SA(1, 1), a1 + hstep, voffA);
            PG8_WAIT_V(8); PG8_WAIT_L(0); PG8_BAR; PG8_MMA(0, 0, At, B0); PG8_MMA(0, 1, At, B1); PG8_BAR; PG8_SCHED;
            PG8_LDA(At, 0, 1); PG8_STAGE(PG8_SB(0, 0), b2, voffB); PG8_STAGE(PG8_SB(0, 1), b2 + hstep, voffB); PG8_STAGE(PG8_SA(0, 0), a2, voffA);
            PG8_WAIT_V(8); PG8_WAIT_L(0); PG8_BAR; PG8_MMA(1, 0, At, B0); PG8_MMA(1, 1, At, B1); PG8_BAR; PG8_SCHED;
            PG8_LDB(B0, 1, 0); PG8_LDB(B1, 1, 1); PG8_SCHED; PG8_LDA(At, 1, 0); PG8_STAGE(PG8_SA(0, 1), a2 + hstep, voffA);
            PG8_WAIT_V(8); PG8_WAIT_L(0); PG8_BAR; PG8_MMA(0, 0, At, B0); PG8_MMA(0, 1, At, B1); PG8_BAR; PG8_SCHED;
            PG8_LDA(At, 1, 1); PG8_STAGE(PG8_SB(1, 0), b3, voffB); PG8_STAGE(PG8_SB(1, 1), b3 + hstep, voffB); PG8_STAGE(PG8_SA(1, 0), a3, voffA);
            PG8_WAIT_V(8); PG8_WAIT_L(0); PG8_BAR; PG8_MMA(1, 0, At, B0); PG8_MMA(1, 1, At, B1); PG8_BAR; PG8_SCHED;
            } else {
            PG8_LDB(B0, 0, 0); PG8_SCHED; PG8_LDA(At, 0, 0); PG8_STAGE(PG8_SA(1, 1), a1 + hstep, voffA);
            PG8_WAIT_L(8); PG8_BAR; PG8_WAIT_L(0); PG8_MMA(0, 0, At, B0); PG8_BAR; PG8_SCHED;
            PG8_LDB(B1, 0, 1); PG8_STAGE(PG8_SB(0, 0), b2, voffB);
            PG8_BAR; PG8_WAIT_L(0); PG8_MMA(0, 1, At, B1); PG8_BAR;
            PG8_LDA(At, 0, 1); PG8_STAGE(PG8_SA(0, 0), a2, voffA);
            PG8_BAR; PG8_WAIT_L(0); PG8_MMA(1, 0, At, B0); PG8_BAR; PG8_SCHED;
            PG8_STAGE(PG8_SB(0, 1), b2 + hstep, voffB);
            PG8_WAIT_V(6); PG8_BAR; PG8_MMA(1, 1, At, B1); PG8_BAR;
            PG8_LDB(B0, 1, 0); PG8_SCHED; PG8_LDA(At, 1, 0); PG8_STAGE(PG8_SA(0, 1), a2 + hstep, voffA);
            PG8_WAIT_L(8); PG8_BAR; PG8_WAIT_L(0); PG8_MMA(0, 0, At, B0); PG8_BAR; PG8_SCHED;
            PG8_LDB(B1, 1, 1); PG8_STAGE(PG8_SB(1, 0), b3, voffB);
            PG8_BAR; PG8_WAIT_L(0); PG8_MMA(0, 1, At, B1); PG8_BAR;
            PG8_LDA(At, 1, 1); PG8_STAGE(PG8_SA(1, 0), a3, voffA);
            PG8_BAR; PG8_WAIT_L(0); PG8_MMA(1, 0, At, B0); PG8_BAR; PG8_SCHED;
            PG8_STAGE(PG8_SB(1, 1), b3 + hstep, voffB);
            PG8_WAIT_V(6); PG8_BAR; PG8_MMA(1, 1, At, B1); PG8_BAR;
            }
        }
        if constexpr (ALIGN_EPI) { if (wr == 0) PG8_BAR; }
        if constexpr (!Epi::AFTER_DRAIN) { E(acc, cur, wr, wc, fr, fq); S.done(cur); }
        if (!has_next) break;
#pragma unroll
        for (int a = 0; a < 2; ++a)
#pragma unroll
            for (int b = 0; b < 2; ++b)
#pragma unroll
                for (int m = 0; m < 4; ++m)
#pragma unroll
                    for (int n = 0; n < 2; ++n) acc[a][b][m][n] = (f32x4){0.f, 0.f, 0.f, 0.f};
        cur = nxt; cA = nA; cB = nB; ++ui;
        if constexpr (ALIGN_EPI) { if (wr == 1) PG8_BAR; }
    }
    PG8_WAIT_V(0);
    if constexpr (!ALIGN_EPI) { if (wr == 0) PG8_BAR; }
    PG8_BAR;
    if constexpr (Epi::AFTER_DRAIN) { E.fused(acc, cur, wr, wc, fr, fq, lds, wid, lane); S.done(cur); }
#undef PG8_SA
#undef PG8_SB
#undef PG8_STAGE
#undef PG8_LDA
#undef PG8_LDB
#undef PG8_MMA
#undef PG8_WAIT_V
#undef PG8_WAIT_L
#undef PG8_BAR
#undef PG8_SCHED
}
}
using pg8::cvt_pk_bf16;

constexpr int M_TOK = 16384, DM = 1024, SEQ = 8192;
constexpr size_t MiB = 1u << 20;
constexpr size_t WS_ROWSQ = 128 * 1024;
constexpr size_t WS_WIN = 1 * MiB;
constexpr size_t WS_WSBHG = 21 * MiB;
constexpr size_t WS_WOUT = 25 * MiB;
constexpr size_t WS_HGD = 27 * MiB;
constexpr size_t WS_H = 28 * MiB;
constexpr size_t WS_SBQ = 60 * MiB;
constexpr size_t WS_HGQ = 92 * MiB;
constexpr size_t WS_SBK = 124 * MiB;
constexpr size_t WS_SBV = 156 * MiB;
constexpr size_t WS_HGI = 188 * MiB;
constexpr size_t WS_ST = 220 * MiB;
constexpr size_t WS_GATES = 124 * MiB;
constexpr size_t WS_Y = 188 * MiB;
constexpr size_t WS_END = 252 * MiB;
constexpr int LDS_BYTES = 163840, LDS_MISC = 163840 - 64;
constexpr float RMS_EPS = 1e-6f;

__device__ __forceinline__ float bf2f(unsigned u) { return __uint_as_float(u << 16); }
__device__ __forceinline__ unsigned f2bf(float f) { unsigned u = __float_as_uint(f); return (u + 0x7fffu + ((u >> 16) & 1u)) >> 16; }
__device__ __forceinline__ unsigned pk2(float lo, float hi) { return f2bf(lo) | (f2bf(hi) << 16); }
__device__ __forceinline__ float sigmoidf_(float v) { return __builtin_amdgcn_rcpf(1.f + __expf(-v)); }
__device__ __forceinline__ float siluf_(float v) { return v * sigmoidf_(v); }
__device__ __forceinline__ float wave_sum(float v) {
#pragma unroll
    for (int o = 1; o < 64; o <<= 1) v += __shfl_xor(v, o);
    return v;
}

struct EpiA {
    static constexpr bool AFTER_DRAIN = false;
    static constexpr bool PERM = true;
    bf16_t* sbq; bf16_t* sbk; bf16_t* sbv; bf16_t* hgq; bf16_t* hgi; float* G; const float* lbl;
    __device__ __forceinline__ void operator()(const f32x4 (&acc)[2][2][4][2], const pg8::Unit& u, int wr, int wc, int fr, int fq) const {
        const int seg = u.pn >> 2;
        const int row0 = u.pm * 256 + wr * 64 + fr, col0 = (u.pn & 3) * 256 + wc * 32 + 8 * fq;
        if (seg == 5) {
#pragma unroll
            for (int bj = 0; bj < 2; ++bj) {
                const int col = col0 + bj * 128;
                float lb[8];
#pragma unroll
                for (int j = 0; j < 8; ++j) lb[j] = __builtin_amdgcn_rcpf(1.f + __expf(lbl[1024 + col + j] - lbl[col + j]));
#pragma unroll
                for (int ai = 0; ai < 2; ++ai)
#pragma unroll
                    for (int m = 0; m < 4; ++m) {
                        bf16_t* p = (bf16_t*)G + (size_t)(row0 + ai * 128 + m * 16) * 1024 + col;
                        f32x4 a = acc[ai][bj][m][0], b = acc[ai][bj][m][1], ga, gb;
#pragma unroll
                        for (int j = 0; j < 4; ++j) { ga[j] = __logf(lb[j] + (1.f - lb[j]) * sigmoidf_(a[j])); gb[j] = __logf(lb[4 + j] + (1.f - lb[4 + j]) * sigmoidf_(b[j])); }
                        u32x4 w; w.x = cvt_pk_bf16(ga[0], ga[1]); w.y = cvt_pk_bf16(ga[2], ga[3]); w.z = cvt_pk_bf16(gb[0], gb[1]); w.w = cvt_pk_bf16(gb[2], gb[3]);
                        *(u32x4*)p = w;
                    }
            }
        } else {
            if (seg == 2) {
#pragma unroll
                for (int ai = 0; ai < 2; ++ai)
#pragma unroll
                    for (int m = 0; m < 4; ++m) {
                        const int row = row0 + ai * 128 + m * 16, bb = row >> 13, ss = row & 8191;
#pragma unroll
                        for (int bj = 0; bj < 2; ++bj) {
                            const int col = col0 + bj * 128;
                            bf16_t* p = sbv + ((size_t)(bb * 1024 + col)) * 8192 + ss;
                            const f32x4 a = acc[ai][bj][m][0], b = acc[ai][bj][m][1];
#pragma unroll
                            for (int j = 0; j < 4; ++j) { p[(size_t)j * 8192] = (bf16_t)f2bf(a[j]); p[(size_t)(4 + j) * 8192] = (bf16_t)f2bf(b[j]); }
                        }
                    }
                return;
            }
            bf16_t* base = seg == 0 ? sbq : seg == 1 ? sbk : seg == 2 ? sbv : seg == 4 ? hgq : hgi;
            const float sc = seg == 0 ? 0.08838834764831845f : 1.f; const bool act = seg == 4;
#pragma unroll
            for (int ai = 0; ai < 2; ++ai)
#pragma unroll
                for (int m = 0; m < 4; ++m)
#pragma unroll
                    for (int bj = 0; bj < 2; ++bj) {
                        f32x4 a = acc[ai][bj][m][0], b = acc[ai][bj][m][1];
                        if (act) {
#pragma unroll
                            for (int j = 0; j < 4; ++j) { a[j] = siluf_(a[j]); b[j] = siluf_(b[j]); } }
                        a = a * sc; b = b * sc;
                        u32x4 w; w.x = cvt_pk_bf16(a[0], a[1]); w.y = cvt_pk_bf16(a[2], a[3]); w.z = cvt_pk_bf16(b[0], b[1]); w.w = cvt_pk_bf16(b[2], b[3]);
                        *(u32x4*)(base + (size_t)(row0 + ai * 128 + m * 16) * 1024 + col0 + bj * 128) = w;
                    }
        }
    }
};
struct EpiB {
    static constexpr bool AFTER_DRAIN = false;
    static constexpr bool PERM = true;
    bf16_t* asb; bf16_t* ahg; bf16_t* gates; const float* bgate;
    __device__ __forceinline__ void operator()(const f32x4 (&acc)[2][2][4][2], const pg8::Unit& u, int wr, int wc, int fr, int fq) const {
        const int seg = u.pn >> 2;
        const int row0 = u.pm * 256 + wr * 64 + fr, col0 = (u.pn & 3) * 256 + wc * 32 + 8 * fq;
        if (seg >= 8) {
#pragma unroll
            for (int bj = 0; bj < 2; ++bj) {
                const int col = (seg - 8) * 1024 + col0 + bj * 128;
                const f32x4 b0 = *(const f32x4*)(bgate + col), b1 = *(const f32x4*)(bgate + col + 4);
#pragma unroll
                for (int ai = 0; ai < 2; ++ai)
#pragma unroll
                    for (int m = 0; m < 4; ++m) {
                        f32x4 a = acc[ai][bj][m][0] + b0, b = acc[ai][bj][m][1] + b1;
#pragma unroll
                        for (int j = 0; j < 4; ++j) { a[j] = sigmoidf_(a[j]); b[j] = sigmoidf_(b[j]); }
                        u32x4 w; w.x = cvt_pk_bf16(a[0], a[1]); w.y = cvt_pk_bf16(a[2], a[3]); w.z = cvt_pk_bf16(b[0], b[1]); w.w = cvt_pk_bf16(b[2], b[3]);
                        *(u32x4*)(gates + (size_t)(row0 + ai * 128 + m * 16) * 2048 + col) = w;
                    }
            }
        } else {
            bf16_t* base = seg == 3 ? asb : ahg;
#pragma unroll
            for (int ai = 0; ai < 2; ++ai) {
                u32x4 ov[4][2];
#pragma unroll
                for (int m = 0; m < 4; ++m)
#pragma unroll
                    for (int bj = 0; bj < 2; ++bj) ov[m][bj] = *(const u32x4*)(base + (size_t)(row0 + ai * 128 + m * 16) * 1024 + col0 + bj * 128);
#pragma unroll
                for (int m = 0; m < 4; ++m)
#pragma unroll
                    for (int bj = 0; bj < 2; ++bj) {
                        const u32x4 o = ov[m][bj];
                        const f32x4 a = acc[ai][bj][m][0], b = acc[ai][bj][m][1];
                        u32x4 w;
                        w.x = cvt_pk_bf16(bf2f(o.x & 0xffffu) * siluf_(a[0]), bf2f(o.x >> 16) * siluf_(a[1]));
                        w.y = cvt_pk_bf16(bf2f(o.y & 0xffffu) * siluf_(a[2]), bf2f(o.y >> 16) * siluf_(a[3]));
                        w.z = cvt_pk_bf16(bf2f(o.z & 0xffffu) * siluf_(b[0]), bf2f(o.z >> 16) * siluf_(b[1]));
                        w.w = cvt_pk_bf16(bf2f(o.w & 0xffffu) * siluf_(b[2]), bf2f(o.w >> 16) * siluf_(b[3]));
                        *(u32x4*)(base + (size_t)(row0 + ai * 128 + m * 16) * 1024 + col0 + bj * 128) = w;
                    }
            }
        }
    }
};
struct EpiC {
    static constexpr bool AFTER_DRAIN = false;
    static constexpr bool PERM = true;
    const bf16_t* gates; float* tmp; bf16_t* Y;
    __device__ __forceinline__ void operator()(const f32x4 (&acc)[2][2][4][2], const pg8::Unit& u, int wr, int wc, int fr, int fq) const {
        const bool second = u.pm >= 64;
        const int pm = second ? u.pm - 64 : u.pm, pn = second ? u.pn - 4 : u.pn;
        const int row0 = pm * 256 + wr * 64 + fr, col0 = pn * 256 + wc * 32 + 8 * fq;
#pragma unroll
        for (int ai = 0; ai < 2; ++ai)
#pragma unroll
        for (int mh = 0; mh < 2; ++mh) {
            u32x4 gv[2][2], tv[2][2];
#pragma unroll
            for (int mm = 0; mm < 2; ++mm)
#pragma unroll
                for (int bj = 0; bj < 2; ++bj) {
                    const size_t row = (size_t)(row0 + ai * 128 + (2 * mh + mm) * 16); const int col = col0 + bj * 128;
                    gv[mm][bj] = *(const u32x4*)(gates + row * 2048 + (second ? 1024 : 0) + col);
                    if (second) tv[mm][bj] = *(const u32x4*)((const bf16_t*)tmp + row * 1024 + col);
                }
#pragma unroll
            for (int mm = 0; mm < 2; ++mm)
#pragma unroll
                for (int bj = 0; bj < 2; ++bj) {
                    const int m = 2 * mh + mm;
                    const size_t row = (size_t)(row0 + ai * 128 + m * 16); const int col = col0 + bj * 128;
                    const u32x4 gt = gv[mm][bj];
                    f32x4 a = acc[ai][bj][m][0], b = acc[ai][bj][m][1];
                    a[0] *= bf2f(gt.x & 0xffffu); a[1] *= bf2f(gt.x >> 16); a[2] *= bf2f(gt.y & 0xffffu); a[3] *= bf2f(gt.y >> 16);
                    b[0] *= bf2f(gt.z & 0xffffu); b[1] *= bf2f(gt.z >> 16); b[2] *= bf2f(gt.w & 0xffffu); b[3] *= bf2f(gt.w >> 16);
                    if (!second) { u32x4 w; w.x = cvt_pk_bf16(a[0], a[1]); w.y = cvt_pk_bf16(a[2], a[3]); w.z = cvt_pk_bf16(b[0], b[1]); w.w = cvt_pk_bf16(b[2], b[3]); *(u32x4*)((bf16_t*)tmp + row * 1024 + col) = w; }
                    else {
                        { const u32x4 t = tv[mm][bj]; a[0] += bf2f(t.x & 0xffffu); a[1] += bf2f(t.x >> 16); a[2] += bf2f(t.y & 0xffffu); a[3] += bf2f(t.y >> 16);
                          b[0] += bf2f(t.z & 0xffffu); b[1] += bf2f(t.z >> 16); b[2] += bf2f(t.w & 0xffffu); b[3] += bf2f(t.w >> 16); }
                        u32x4 w; w.x = cvt_pk_bf16(a[0], a[1]); w.y = cvt_pk_bf16(a[2], a[3]); w.z = cvt_pk_bf16(b[0], b[1]); w.w = cvt_pk_bf16(b[2], b[3]);
                        *(u32x4*)(Y + row * 1024 + col) = w;
                    }
                }
        }
    }
};
struct EpiD {
    static constexpr bool PERM = true, AFTER_DRAIN = true;
    const float* x; float* out; const float* fng; float* xb; unsigned* cnt;
    __device__ __forceinline__ void operator()(const f32x4 (&)[2][2][4][2], const pg8::Unit&, int, int, int, int) const {}
    __device__ __forceinline__ void fused(f32x4 (&acc)[2][2][4][2], const pg8::Unit& u, int wr, int wc, int fr, int fq, LAS unsigned char* lds, int wid, int lane) const {
        const int tid = threadIdx.x;
        const int row0 = u.pm * 256 + wr * 64 + fr, col0 = u.pn * 256 + wc * 32 + 8 * fq;
        LAS float* P = (LAS float*)lds;
        LAS float* Sr = (LAS float*)(lds + 4096);
#pragma unroll
        for (int ai = 0; ai < 2; ++ai) {
            f32x4 xa[4][2], xc[4][2];
#pragma unroll
            for (int m = 0; m < 4; ++m)
#pragma unroll
                for (int bj = 0; bj < 2; ++bj) {
                    const size_t off = (size_t)(row0 + ai * 128 + m * 16) * 1024 + col0 + bj * 128;
                    xa[m][bj] = *(const f32x4*)(x + off); xc[m][bj] = *(const f32x4*)(x + off + 4);
                }
#pragma unroll
            for (int m = 0; m < 4; ++m) {
                float ss = 0.f;
#pragma unroll
                for (int bj = 0; bj < 2; ++bj) {
                    const f32x4 a = acc[ai][bj][m][0] + xa[m][bj], b = acc[ai][bj][m][1] + xc[m][bj];
                    acc[ai][bj][m][0] = a; acc[ai][bj][m][1] = b;
                    ss += (a[0] * a[0] + a[1] * a[1]) + (a[2] * a[2] + a[3] * a[3]) + (b[0] * b[0] + b[1] * b[1]) + (b[2] * b[2] + b[3] * b[3]);
                }
                ss += __shfl_xor(ss, 16); ss += __shfl_xor(ss, 32);
                if (fq == 0) P[(ai * 128 + wr * 64 + m * 16 + fr) * 4 + wc] = ss;
            }
        }
        __syncthreads();
        if (tid < 256) {
            const float t = (P[tid * 4] + P[tid * 4 + 1]) + (P[tid * 4 + 2] + P[tid * 4 + 3]);
            __hip_atomic_store(xb + ((size_t)(u.pm * 4 + u.pn)) * 256 + tid, t, __ATOMIC_RELAXED, __HIP_MEMORY_SCOPE_AGENT);
        }
        asm volatile("s_waitcnt vmcnt(0)" ::: "memory");
        __syncthreads();
        if (tid == 0) {
            unsigned* c = cnt + 64 * u.pm;
            (void)__hip_atomic_fetch_add(c, 1u, __ATOMIC_RELAXED, __HIP_MEMORY_SCOPE_AGENT);
            unsigned sp = 0;
            while (__hip_atomic_load(c, __ATOMIC_RELAXED, __HIP_MEMORY_SCOPE_AGENT) < 4u) { __builtin_amdgcn_s_sleep(2); if (++sp > (1u << 22)) break; }
            __builtin_amdgcn_fence(__ATOMIC_ACQUIRE, "agent");
            asm volatile("s_waitcnt vmcnt(0)" ::: "memory");
        }
        __syncthreads();
        if (tid < 256) {
            float t = 0.f;
#pragma unroll
            for (int pn = 0; pn < 4; ++pn) t += __hip_atomic_load(xb + ((size_t)(u.pm * 4 + pn)) * 256 + tid, __ATOMIC_RELAXED, __HIP_MEMORY_SCOPE_AGENT);
            Sr[tid] = __builtin_amdgcn_rsqf(t * (1.f / 1024.f) + RMS_EPS);
        }
        __syncthreads();
#pragma unroll
        for (int bj = 0; bj < 2; ++bj) {
            const f32x4 g0 = *(const f32x4*)(fng + col0 + bj * 128), g1 = *(const f32x4*)(fng + col0 + bj * 128 + 4);
#pragma unroll
            for (int ai = 0; ai < 2; ++ai)
#pragma unroll
                for (int m = 0; m < 4; ++m) {
                    const float rstd = Sr[ai * 128 + wr * 64 + m * 16 + fr];
                    const size_t off = (size_t)(row0 + ai * 128 + m * 16) * 1024 + col0 + bj * 128;
                    *(f32x4*)(out + off) = acc[ai][bj][m][0] * rstd * g0; *(f32x4*)(out + off + 4) = acc[ai][bj][m][1] * rstd * g1;
                }
        }
    }
};

__device__ __forceinline__ void p0_transpose_kn(const float* W, int K, int N, bf16_t* WT, int row_off, LAS float* scr, int kb, int nb, int lane) {
    const int k0 = 64 * kb, n0 = 32 * nb;
    float wv[32];
#pragma unroll
    for (int i = 0; i < 32; ++i) wv[i] = W[(size_t)(k0 + 2 * i + (lane >> 5)) * N + n0 + (lane & 31)];
#pragma unroll
    for (int i = 0; i < 32; ++i) scr[(2 * i + (lane >> 5)) * 33 + (lane & 31)] = wv[i];
    asm volatile("s_waitcnt lgkmcnt(0)" ::: "memory");
    const int c = lane & 7;
#pragma unroll
    for (int j = 0; j < 4; ++j) { const int n = (lane >> 3) + 8 * j; const LAS float* s = scr + (8 * c) * 33 + n;
        u32x4 o; o.x = pk2(s[0 * 33], s[1 * 33]); o.y = pk2(s[2 * 33], s[3 * 33]); o.z = pk2(s[4 * 33], s[5 * 33]); o.w = pk2(s[6 * 33], s[7 * 33]);
        *(u32x4*)(WT + (size_t)(row_off + n0 + n) * K + k0 + 8 * c) = o; }
    asm volatile("s_waitcnt lgkmcnt(0)" ::: "memory");
}

constexpr int SB_KW = 0, SB_VW = 69632, SB_ZS = 137216;
__device__ __forceinline__ void sb_unit(LAS unsigned char* lds, int unit, bf16_t* Q, const bf16_t* Kb, const bf16_t* VT) {
    const int tid = threadIdx.x, lane = tid & 63, w = tid >> 6, r = lane & 15, g = lane >> 4;
    const int bh = unit >> 6, qb = unit & 63, b = bh >> 3, h = bh & 7;
    const size_t rowbase = (size_t)b * SEQ;
    const int tblk = qb * 128, kwin0 = tblk >= 128 ? tblk - 128 : 0;
    LAS bf16_t* Kw = (LAS bf16_t*)(lds + SB_KW);
    LAS bf16_t* Vw = (LAS bf16_t*)(lds + SB_VW);
    LAS float* Zs = (LAS float*)(lds + SB_ZS) + w * (16 * 36);
    {
        u32x4 kv[8], vv[8];
#pragma unroll
        for (int i = 0; i < 8; ++i) { const int c = tid + 512 * i, key = c >> 4, dc = c & 15;
            kv[i] = *(const u32x4*)(Kb + (rowbase + kwin0 + key) * 1024 + h * 128 + 8 * dc); }
#pragma unroll
        for (int i = 0; i < 8; ++i) { const int c = tid + 512 * i, row = c >> 5, kc = c & 31;
            vv[i] = *(const u32x4*)(VT + ((size_t)(bh * 128 + row)) * 8192 + kwin0 + 8 * kc); }
        __syncthreads();
#pragma unroll
        for (int i = 0; i < 8; ++i) { const int c = tid + 512 * i, key = c >> 4, dc = c & 15; *(LAS u32x4*)(Kw + key * 136 + 8 * dc) = kv[i]; }
#pragma unroll
        for (int i = 0; i < 8; ++i) { const int c = tid + 512 * i, row = c >> 5, kc = c & 31; *(LAS u32x4*)(Vw + row * 264 + 8 * kc) = vv[i]; }
    }
    const int t0 = tblk + 16 * w;
    bf16x8 qf[4];
    {
        const bf16_t* qrow = Q + (rowbase + t0 + r) * 1024 + h * 128 + 8 * g;
#pragma unroll
        for (int kk = 0; kk < 4; ++kk) qf[kk] = *(const bf16x8*)(qrow + 32 * kk);
    }
    f32x4 o[8];
#pragma unroll
    for (int n = 0; n < 8; ++n) o[n] = (f32x4){0.f, 0.f, 0.f, 0.f};
    float sacc = 0.f;
    const int t_abs = t0 + r;
    const bf16_t* kbase = Kb + (rowbase + r) * 1024 + h * 128 + 8 * g;
    const bf16_t* vbase = VT + ((size_t)(bh * 128 + r)) * 8192 + 8 * g;
    __syncthreads();
    for (int kt = (t0 + 15) >> 5; kt >= 0; --kt) {
        const int key0 = 32 * kt;
        bf16x8 kf[8], vf[8];
        if (key0 >= kwin0) {
            const LAS bf16_t* kp = Kw + (key0 - kwin0 + r) * 136 + 8 * g;
            const LAS bf16_t* vp = Vw + r * 264 + (key0 - kwin0) + 8 * g;
#pragma unroll
            for (int n = 0; n < 2; ++n)
#pragma unroll
                for (int kk = 0; kk < 4; ++kk) kf[4 * n + kk] = *(const LAS bf16x8*)(kp + (16 * n) * 136 + 32 * kk);
#pragma unroll
            for (int n = 0; n < 8; ++n) vf[n] = *(const LAS bf16x8*)(vp + (16 * n) * 264);
        } else {
#pragma unroll
            for (int n = 0; n < 2; ++n)
#pragma unroll
                for (int kk = 0; kk < 4; ++kk) kf[4 * n + kk] = *(const bf16x8*)(kbase + (size_t)(key0 + 16 * n) * 1024 + 32 * kk);
#pragma unroll
            for (int n = 0; n < 8; ++n) vf[n] = *(const bf16x8*)(vbase + (size_t)(16 * n) * 8192 + key0);
        }
#pragma unroll
        for (int n = 0; n < 2; ++n) {
            f32x4 z = (f32x4){0.f, 0.f, 0.f, 0.f};
#pragma unroll
            for (int kk = 0; kk < 4; ++kk) z = __builtin_amdgcn_mfma_f32_16x16x32_bf16(qf[kk], kf[4 * n + kk], z, 0, 0, 0);
#pragma unroll
            for (int rg = 0; rg < 4; ++rg) Zs[(4 * g + rg) * 36 + 16 * n + r] = z[rg];
        }
        __builtin_amdgcn_wave_barrier();
        bf16x8 afr;
        {
            float zz[8], sp[8];
#pragma unroll
            for (int i = 0; i < 2; ++i) { const f32x4 v = *(const LAS f32x4*)(Zs + r * 36 + 8 * g + 4 * i); zz[4 * i] = v[0]; zz[4 * i + 1] = v[1]; zz[4 * i + 2] = v[2]; zz[4 * i + 3] = v[3]; }
            const int j0 = key0 + 8 * g;
            float run = 0.f;
#pragma unroll
            for (int i = 7; i >= 0; --i) {
                const bool valid = (j0 + i) < t_abs;
                const float s = fmaxf(zz[i], 0.f) + __logf(1.f + __expf(-fabsf(zz[i])));
                sp[i] = valid ? s : 0.f; zz[i] = zz[i] - s; run += sp[i];
            }
            const float tot = run;
            const float t1 = __shfl_xor(tot, 16), t2 = __shfl_xor(tot, 32), t3 = __shfl_xor(t1, 32);
            const float after = (g == 0) ? (t1 + t2 + t3) : (g == 1) ? (t2 + t3) : (g == 2) ? t1 : 0.f;
            float sub = after + sacc;
            unsigned pw[4];
#pragma unroll
            for (int i = 3; i >= 0; --i) {
                const bool v1 = (j0 + 2 * i + 1) < t_abs, v0 = (j0 + 2 * i) < t_abs;
                const float w1 = v1 ? __expf(zz[2 * i + 1] - sub) : 0.f; sub += sp[2 * i + 1];
                const float w0 = v0 ? __expf(zz[2 * i] - sub) : 0.f; sub += sp[2 * i];
                pw[i] = cvt_pk_bf16(w0, w1);
            }
            afr = __builtin_bit_cast(bf16x8, ((u32x4){pw[0], pw[1], pw[2], pw[3]}));
            sacc += tot + t1 + t2 + t3;
        }
        __builtin_amdgcn_wave_barrier();
#pragma unroll
        for (int n = 0; n < 8; ++n) o[n] = __builtin_amdgcn_mfma_f32_16x16x32_bf16(afr, vf[n], o[n], 0, 0, 0);
        float mn = sacc;
#pragma unroll
        for (int s = 1; s < 16; s <<= 1) mn = fminf(mn, __shfl_xor(mn, s));
        if (mn > 104.f) break;
    }
#pragma unroll
    for (int n = 0; n < 8; ++n)
#pragma unroll
        for (int rg = 0; rg < 4; ++rg)
            Q[(rowbase + t0 + 4 * g + rg) * 1024 + h * 128 + 16 * n + r] = (bf16_t)f2bf(o[n][rg]);
}

__device__ __forceinline__ void grp_arrive(unsigned* c) {
    asm volatile("s_waitcnt vmcnt(0)" ::: "memory");
    __syncthreads();
    if (threadIdx.x == 0) (void)__hip_atomic_fetch_add(c, 1u, __ATOMIC_RELAXED, __HIP_MEMORY_SCOPE_AGENT);
}
__device__ __forceinline__ void grp_wait(unsigned* c, unsigned target) {
    if (threadIdx.x == 0) {
        unsigned sp = 0;
        while (__hip_atomic_load(c, __ATOMIC_RELAXED, __HIP_MEMORY_SCOPE_AGENT) < target) { __builtin_amdgcn_s_sleep(2); if (++sp > (1u << 22)) break; }
        __builtin_amdgcn_fence(__ATOMIC_ACQUIRE, "agent");
        asm volatile("s_waitcnt vmcnt(0)" ::: "memory");
    }
    __syncthreads();
}

constexpr int HG_QT = 0, HG_KT = 17408, HG_KD = 34816, HG_VT = 53248, HG_AS = 71680, HG_SP = 80896, HG_PT = 115712, HG_DL = 117760, HG_DM = 118272;
struct HgRegs { float gv[16]; unsigned vv[16]; unsigned qv[16]; };
template <bool FULL>
__device__ __forceinline__ void hg_load(HgRegs& R, size_t m0, int h, const float* G, const bf16_t* HQ, const bf16_t* HI) {
    const int tid = threadIdx.x, k = tid & 127, part = tid >> 7;
    const size_t base = (m0 + 16 * part) * 1024 + h * 128 + k;
#pragma unroll
    for (int i = 0; i < 16; ++i) R.gv[i] = bf2f(((const bf16_t*)G)[base + (size_t)i * 1024]);
#pragma unroll
    for (int i = 0; i < 16; ++i) R.vv[i] = HI[base + (size_t)i * 1024];
    if (FULL) {
#pragma unroll
        for (int i = 0; i < 16; ++i) R.qv[i] = HQ[base + (size_t)i * 1024];
    }
}
template <bool FULL>
__device__ __forceinline__ float hg_prep(LAS unsigned char* lds, const HgRegs& R) {
    const int tid = threadIdx.x, k = tid & 127, part = tid >> 7;
    LAS float* ptot = (LAS float*)(lds + HG_PT);
    float gv[16], cs[16];
    float run = 0.f;
#pragma unroll
    for (int i = 0; i < 16; ++i) { gv[i] = R.gv[i]; run += gv[i]; cs[i] = run; }
    ptot[part * 128 + k] = run;
    unsigned vv[16];
#pragma unroll
    for (int i = 0; i < 16; ++i) vv[i] = R.vv[i];
    __syncthreads();
    const float p0 = ptot[k], p1 = ptot[128 + k], p2 = ptot[256 + k], p3 = ptot[384 + k];
    const float off = (part == 0) ? 0.f : (part == 1) ? p0 : (part == 2) ? (p0 + p1) : (p0 + p1 + p2);
    const float last = (p0 + p1) + (p2 + p3), mid = p0 + p1;
    LAS bf16_t* kdT = (LAS bf16_t*)(lds + HG_KD);
    LAS bf16_t* vT = (LAS bf16_t*)(lds + HG_VT);
    unsigned pk[8];
    float kkv[16], em[16];
    const float clm = __expf(last - mid);
#pragma unroll
    for (int i = 0; i < 16; ++i) { kkv[i] = 1.f - __expf(gv[i]); em[i] = __expf((FULL ? mid : last) - (cs[i] + off)); }
#pragma unroll
    for (int i = 0; i < 8; ++i) {
        const float a = kkv[2 * i] * em[2 * i] * (FULL ? clm : 1.f), c = kkv[2 * i + 1] * em[2 * i + 1] * (FULL ? clm : 1.f);
        pk[i] = cvt_pk_bf16(a, c);
    }
    *(LAS u32x4*)(kdT + k * 72 + 16 * part) = (u32x4){pk[0], pk[1], pk[2], pk[3]};
    *(LAS u32x4*)(kdT + k * 72 + 16 * part + 8) = (u32x4){pk[4], pk[5], pk[6], pk[7]};
    *(LAS u32x4*)(vT + k * 72 + 16 * part) = (u32x4){vv[0] | (vv[1] << 16), vv[2] | (vv[3] << 16), vv[4] | (vv[5] << 16), vv[6] | (vv[7] << 16)};
    *(LAS u32x4*)(vT + k * 72 + 16 * part + 8) = (u32x4){vv[8] | (vv[9] << 16), vv[10] | (vv[11] << 16), vv[12] | (vv[13] << 16), vv[14] | (vv[15] << 16)};
    if (FULL) {
        LAS bf16_t* qt = (LAS bf16_t*)(lds + HG_QT);
        LAS bf16_t* kt = (LAS bf16_t*)(lds + HG_KT);
#pragma unroll
        for (int i = 0; i < 16; ++i) {
            const float q = bf2f(R.qv[i]);
            qt[(16 * part + i) * 136 + k] = (bf16_t)f2bf(q * __builtin_amdgcn_rcpf(em[i]));
            kt[(16 * part + i) * 136 + k] = (bf16_t)f2bf(kkv[i] * em[i]);
        }
    }
    if (part == 0) { ((LAS float*)(lds + HG_DL))[k] = __expf(last); if (FULL) ((LAS float*)(lds + HG_DM))[k] = __expf(mid); }
    return last;
}
__device__ __forceinline__ void hg_state_update(LAS unsigned char* lds, f32x4 (&S)[8], int w, int r, int g) {
    const LAS bf16_t* kdT = (const LAS bf16_t*)(lds + HG_KD);
    const LAS bf16_t* vT = (const LAS bf16_t*)(lds + HG_VT);
    const LAS float* dl = (const LAS float*)(lds + HG_DL);
    const bf16x8 b0 = *(const LAS bf16x8*)(vT + (16 * w + r) * 72 + 8 * g), b1 = *(const LAS bf16x8*)(vT + (16 * w + r) * 72 + 32 + 8 * g);
#pragma unroll
    for (int i = 0; i < 8; ++i) {
        const f32x4 d = *(const LAS f32x4*)(dl + 16 * i + 4 * g);
        S[i] = S[i] * d;
        const bf16x8 a0 = *(const LAS bf16x8*)(kdT + (16 * i + r) * 72 + 8 * g), a1 = *(const LAS bf16x8*)(kdT + (16 * i + r) * 72 + 32 + 8 * g);
        S[i] = __builtin_amdgcn_mfma_f32_16x16x32_bf16(a0, b0, S[i], 0, 0, 0);
        S[i] = __builtin_amdgcn_mfma_f32_16x16x32_bf16(a1, b1, S[i], 0, 0, 0);
    }
}
__device__ __forceinline__ void hg_unit_a(LAS unsigned char* lds, int unit, const float* G, const bf16_t* HI, float* ST, float* DG, unsigned* cnt) {
    const int tid = threadIdx.x, lane = tid & 63, w = tid >> 6, r = lane & 15, g = lane >> 4;
    const int bh = unit >> 5, c = unit & 31, b = bh >> 3, h = bh & 7;
    f32x4 S[8];
#pragma unroll
    for (int i = 0; i < 8; ++i) S[i] = (f32x4){0.f, 0.f, 0.f, 0.f};
    float cumtot = 0.f;
    HgRegs R;
    const size_t mu = (size_t)b * SEQ + c * 256;
    hg_load<false>(R, mu, h, G, nullptr, HI);
    for (int sc = 0; sc < 4; ++sc) {
        __syncthreads();
        cumtot += hg_prep<false>(lds, R);
        if (sc < 3) hg_load<false>(R, mu + (sc + 1) * 64, h, G, nullptr, HI);
        __syncthreads();
        hg_state_update(lds, S, w, r, g);
    }
    float* U = ST + (size_t)unit * 16384;
#pragma unroll
    for (int i = 0; i < 8; ++i)
#pragma unroll
        for (int rg = 0; rg < 4; ++rg) __hip_atomic_store(&U[(16 * i + 4 * g + rg) * 128 + 16 * w + r], S[i][rg], __ATOMIC_RELAXED, __HIP_MEMORY_SCOPE_AGENT);
    if (tid < 128) __hip_atomic_store(&DG[unit * 128 + tid], __expf(cumtot), __ATOMIC_RELAXED, __HIP_MEMORY_SCOPE_AGENT);
    if (cnt) grp_arrive(cnt + 64 * bh);
}
__device__ __forceinline__ void hg_unit_c(LAS unsigned char* lds, int unit, const float* G, bf16_t* HQ, const bf16_t* HI, const float* ST, const float* ng) {
    const int tid = threadIdx.x, lane = tid & 63, w = tid >> 6, r = lane & 15, g = lane >> 4;
    const int bh = unit >> 5, c = unit & 31, b = bh >> 3, h = bh & 7;
    f32x4 S[8];
    {
        const float* U = ST + (size_t)unit * 16384;
#pragma unroll
        for (int i = 0; i < 8; ++i)
#pragma unroll
            for (int rg = 0; rg < 4; ++rg) S[i][rg] = U[(16 * i + 4 * g + rg) * 128 + 16 * w + r];
    }
    LAS bf16_t* qt = (LAS bf16_t*)(lds + HG_QT);
    LAS bf16_t* kt = (LAS bf16_t*)(lds + HG_KT);
    LAS bf16_t* vT = (LAS bf16_t*)(lds + HG_VT);
    LAS bf16_t* As = (LAS bf16_t*)(lds + HG_AS);
    LAS bf16_t* SpT = (LAS bf16_t*)(lds + HG_SP) + w * (16 * 136);
    LAS float* Os = (LAS float*)(lds + HG_QT);
    const LAS float* dm = (const LAS float*)(lds + HG_DM);
    HgRegs R;
    hg_load<true>(R, (size_t)b * SEQ + c * 256, h, G, HQ, HI);
    for (int sc = 0; sc < 4; ++sc) {
        const size_t m0 = (size_t)b * SEQ + c * 256 + sc * 64;
        __syncthreads();
        (void)hg_prep<true>(lds, R);
        if (sc < 3) hg_load<true>(R, m0 + 64, h, G, HQ, HI);
        __syncthreads();
#pragma unroll
        for (int i = 0; i < 8; ++i) {
            const f32x4 d = *(const LAS f32x4*)(dm + 16 * i + 4 * g);
            const f32x4 s = S[i] * d;
            *(LAS u32x2*)(SpT + r * 136 + 16 * i + 4 * g) = (u32x2){cvt_pk_bf16(s[0], s[1]), cvt_pk_bf16(s[2], s[3])};
        }
#pragma unroll
        for (int tt = 0; tt < 2; ++tt) {
            const int tile = 2 * w + tt, ti = tile >> 2, si = tile & 3;
            f32x4 a = (f32x4){0.f, 0.f, 0.f, 0.f};
            if (si <= ti) {
#pragma unroll
                for (int kk = 0; kk < 4; ++kk) {
                    const bf16x8 af = *(const LAS bf16x8*)(qt + (16 * ti + r) * 136 + 32 * kk + 8 * g);
                    const bf16x8 bf = *(const LAS bf16x8*)(kt + (16 * si + r) * 136 + 32 * kk + 8 * g);
                    a = __builtin_amdgcn_mfma_f32_16x16x32_bf16(af, bf, a, 0, 0, 0);
                }
            }
#pragma unroll
            for (int rg = 0; rg < 4; ++rg) {
                const int t = 16 * ti + 4 * g + rg, s = 16 * si + r;
                As[t * 72 + s] = (bf16_t)f2bf((s <= t) ? a[rg] : 0.f);
            }
        }
        __syncthreads();
        f32x4 o[4];
        {
            const bf16x8 vb0 = *(const LAS bf16x8*)(vT + (16 * w + r) * 72 + 8 * g), vb1 = *(const LAS bf16x8*)(vT + (16 * w + r) * 72 + 32 + 8 * g);
            bf16x8 sb[4];
#pragma unroll
            for (int kk = 0; kk < 4; ++kk) sb[kk] = *(const LAS bf16x8*)(SpT + r * 136 + 32 * kk + 8 * g);
#pragma unroll
            for (int ti = 0; ti < 4; ++ti) {
                f32x4 a = (f32x4){0.f, 0.f, 0.f, 0.f};
                const bf16x8 a0 = *(const LAS bf16x8*)(As + (16 * ti + r) * 72 + 8 * g), a1 = *(const LAS bf16x8*)(As + (16 * ti + r) * 72 + 32 + 8 * g);
                a = __builtin_amdgcn_mfma_f32_16x16x32_bf16(a0, vb0, a, 0, 0, 0);
                a = __builtin_amdgcn_mfma_f32_16x16x32_bf16(a1, vb1, a, 0, 0, 0);
#pragma unroll
                for (int kk = 0; kk < 4; ++kk) {
                    const bf16x8 qf = *(const LAS bf16x8*)(qt + (16 * ti + r) * 136 + 32 * kk + 8 * g);
                    a = __builtin_amdgcn_mfma_f32_16x16x32_bf16(qf, sb[kk], a, 0, 0, 0);
                }
                o[ti] = a;
            }
        }
        hg_state_update(lds, S, w, r, g);
        __syncthreads();
#pragma unroll
        for (int ti = 0; ti < 4; ++ti)
#pragma unroll
            for (int rg = 0; rg < 4; ++rg) Os[(16 * ti + 4 * g + rg) * 132 + 16 * w + r] = o[ti][rg];
        __syncthreads();
        {
            const int t = tid >> 3, sg = tid & 7;
            f32x4 v[4]; float ss = 0.f;
#pragma unroll
            for (int i = 0; i < 4; ++i) { v[i] = *(const LAS f32x4*)(Os + t * 132 + 16 * sg + 4 * i); ss += (v[i][0] * v[i][0] + v[i][1] * v[i][1]) + (v[i][2] * v[i][2] + v[i][3] * v[i][3]); }
            ss += __shfl_xor(ss, 1); ss += __shfl_xor(ss, 2); ss += __shfl_xor(ss, 4);
            const float rstd = __builtin_amdgcn_rsqf(ss * (1.f / 128.f) + RMS_EPS);
            const float* gp = ng + h * 128 + 16 * sg;
            unsigned pk[8];
#pragma unroll
            for (int i = 0; i < 4; ++i) {
                const f32x4 gg = *(const f32x4*)(gp + 4 * i);
                pk[2 * i] = cvt_pk_bf16(v[i][0] * rstd * gg[0], v[i][1] * rstd * gg[1]);
                pk[2 * i + 1] = cvt_pk_bf16(v[i][2] * rstd * gg[2], v[i][3] * rstd * gg[3]);
            }
            bf16_t* op = HQ + (m0 + t) * 1024 + h * 128 + 16 * sg;
            *(u32x4*)op = (u32x4){pk[0], pk[1], pk[2], pk[3]};
            *(u32x4*)(op + 8) = (u32x4){pk[4], pk[5], pk[6], pk[7]};
        }
    }
}

#define XB_TMO      128
#define XB_XCNT(j)  (256  + 64 * (j))
#define XB_XSUB(j)  (1280 + 64 * (j))
#define XB_XGEN(j)  (2304 + 64 * (j))
#define XB_TOP      3328
#define XB_TOPGEN   3392
#define XCD_BAR_WORDS 3456
#define XB_SPIN_CAP (1u << 18)
__device__ __forceinline__ unsigned xb_ld(unsigned* p)              { return __hip_atomic_load(p, __ATOMIC_RELAXED, __HIP_MEMORY_SCOPE_AGENT); }
__device__ __forceinline__ unsigned xb_add(unsigned* p, unsigned v) { return __hip_atomic_fetch_add(p, v, __ATOMIC_RELAXED, __HIP_MEMORY_SCOPE_AGENT); }
__device__ __forceinline__ unsigned xb_xcc_id() { return (unsigned)__builtin_amdgcn_s_getreg((3 << 11) | 20) & 0xFu; }
#define XB_SPIN(cond, bar) do { unsigned _sp = 0; while (cond) { __builtin_amdgcn_s_sleep(1); \
    if ((++_sp & 255u) == 0u) { if (xb_ld(&(bar)[XB_TMO])) break; if (_sp > XB_SPIN_CAP) { atomicAdd(&(bar)[XB_TMO], 1u); break; } } } } while (0)
struct XcdBarrier { unsigned* bar; unsigned x; volatile LAS unsigned* st; };
__device__ __forceinline__ XcdBarrier xcd_barrier_post(unsigned* bar, volatile LAS unsigned* st) {
    XcdBarrier b; b.bar = bar; b.x = xb_xcc_id(); b.st = st;
    if (threadIdx.x == 0) (void)xb_add(&bar[XB_XCNT(b.x)], 1u);
    return b;
}
__device__ __forceinline__ void xcd_barrier_complete(unsigned* bar, unsigned x, unsigned& nloc, unsigned& nx) {
    const unsigned G = gridDim.x * gridDim.y * gridDim.z;
    unsigned sum, cnt, mine, sp = 0u;
    for (;;) {
        sum = 0u; cnt = 0u; mine = 0u;
#pragma unroll
        for (unsigned j = 0; j < 16; ++j) { const unsigned c = xb_ld(&bar[XB_XCNT(j)]); sum += c; cnt += (c > 0u) ? 1u : 0u; mine = (j == x) ? c : mine; }
        if (sum == G) break;
        __builtin_amdgcn_s_sleep(1);
        if ((++sp & 255u) == 0u) { if (xb_ld(&bar[XB_TMO])) break; if (sp > XB_SPIN_CAP) { atomicAdd(&bar[XB_TMO], 1u); break; } }
    }
    nloc = mine > 0u ? mine : 1u; nx = cnt > 0u ? cnt : 1u;
}
__device__ __forceinline__ void xcd_barrier(const XcdBarrier& b) {
    asm volatile("s_waitcnt vmcnt(0)" ::: "memory");
    __syncthreads();
    if (threadIdx.x == 0) {
        unsigned* bar = b.bar;
        __builtin_amdgcn_s_waitcnt(0);
        unsigned nloc = b.st[0], nx = b.st[1];
        if (nloc == 0u) { xcd_barrier_complete(bar, b.x, nloc, nx); b.st[0] = nloc; b.st[1] = nx; }
        const unsigned old = xb_add(&bar[XB_XSUB(b.x)], 1u);
        const unsigned gen = old / nloc;
        if (old + 1u == (gen + 1u) * nloc) {
            __builtin_amdgcn_fence(__ATOMIC_RELEASE, "agent");
            asm volatile("s_waitcnt vmcnt(0)" ::: "memory");
            const unsigned og = xb_add(&bar[XB_TOP], 1u);
            const unsigned tg = og / nx;
            if (og + 1u == (tg + 1u) * nx) xb_add(&bar[XB_TOPGEN], 1u);
            else XB_SPIN(xb_ld(&bar[XB_TOPGEN]) == tg, bar);
            __builtin_amdgcn_fence(__ATOMIC_ACQUIRE, "agent");
            xb_add(&bar[XB_XGEN(b.x)], 1u);
            asm volatile("s_waitcnt vmcnt(0)" ::: "memory");
        } else {
            XB_SPIN(xb_ld(&bar[XB_XGEN(b.x)]) == gen, bar);
            __builtin_amdgcn_fence(__ATOMIC_ACQUIRE, "agent");
            asm volatile("s_waitcnt vmcnt(0)" ::: "memory");
        }
    }
    __syncthreads();
}

struct Args { const float* in[10]; float* out; unsigned char* ws; int ph_lo, ph_hi; };
__global__ void __launch_bounds__(512, 2) mk_fwd(Args args) {
    extern __shared__ __attribute__((aligned(16))) unsigned char lds_raw[];
    LAS unsigned char* lds = (LAS unsigned char*)lds_raw;
    cg::grid_group grid = cg::this_grid();
    const int tid = threadIdx.x, lane = tid & 63, wave = tid >> 6;
    const int G = gridDim.x, bid = blockIdx.x;
    unsigned char* ws = args.ws;
    const float* x = args.in[0]; const float* norm_g = args.in[1]; const float* w_in = args.in[2]; const float* b_gate = args.in[3];
    const float* lb_logits = args.in[4]; const float* hg_norm_g = args.in[5]; const float* w_sb = args.in[6]; const float* w_hg = args.in[7];
    const float* w_out = args.in[8]; const float* fng = args.in[9];
    float* out = args.out;
    bf16_t* Wt_in = (bf16_t*)(ws + WS_WIN); bf16_t* Wt_sbhg = (bf16_t*)(ws + WS_WSBHG); bf16_t* Wt_out = (bf16_t*)(ws + WS_WOUT);
    float* DG = (float*)(ws + WS_HGD);
    bf16_t* Hn = (bf16_t*)(ws + WS_H); bf16_t* SBQ = (bf16_t*)(ws + WS_SBQ); bf16_t* HGQ = (bf16_t*)(ws + WS_HGQ);
    bf16_t* SBK = (bf16_t*)(ws + WS_SBK); bf16_t* SBV = (bf16_t*)(ws + WS_SBV); bf16_t* HGI = (bf16_t*)(ws + WS_HGI);
    float* ST = (float*)(ws + WS_ST); bf16_t* GATES = (bf16_t*)(ws + WS_GATES); bf16_t* Y = (bf16_t*)(ws + WS_Y);
    float* Gf = out;
    const int lo = args.ph_lo, hi = args.ph_hi;
    if (lo < 0) grid.sync();
    if (tid < 16) ((LAS unsigned*)(lds + LDS_MISC))[tid] = 0u;
    __syncthreads();
    XcdBarrier bar = xcd_barrier_post((unsigned*)ws, (volatile LAS unsigned*)(lds + LDS_MISC));
#define IN(k) (lo <= (k) && (k) < hi)
#define SEAM(k) do { if (IN(k) && IN((k) + 1)) xcd_barrier(bar); } while (0)

    if (IN(0)) {
        LAS float* scr = (LAS float*)(lds + wave * 16384);
        const int gw = bid * 8 + wave, NGW = G * 8;
        for (int it = gw; it < 16 * 192; it += NGW) {
            const int kb = it / 192, j = it % 192, sg = j >> 5, seg = sg < 3 ? sg : sg + 1;
            p0_transpose_kn(w_in, 1024, 10240, Wt_in, 0, scr, kb, seg * 32 + (j & 31), lane);
        }
        for (int m4 = gw * 4; m4 < M_TOK; m4 += NGW * 4) {
            f32x4 v[4][4]; float s2[4];
#pragma unroll
            for (int q = 0; q < 4; ++q) { const f32x4* xr = (const f32x4*)(x + (size_t)(m4 + q) * 1024) + lane;
#pragma unroll
                for (int j = 0; j < 4; ++j) v[q][j] = xr[64 * j]; }
#pragma unroll
            for (int q = 0; q < 4; ++q) { s2[q] = 0.f;
#pragma unroll
                for (int j = 0; j < 4; ++j) s2[q] += (v[q][j][0] * v[q][j][0] + v[q][j][1] * v[q][j][1]) + (v[q][j][2] * v[q][j][2] + v[q][j][3] * v[q][j][3]); }
#pragma unroll
            for (int o = 1; o < 64; o <<= 1) {
#pragma unroll
                for (int q = 0; q < 4; ++q) s2[q] += __shfl_xor(s2[q], o); }
#pragma unroll
            for (int q = 0; q < 4; ++q) {
                const float rstd = __builtin_amdgcn_rsqf(s2[q] * (1.f / 1024.f) + RMS_EPS);
                u32x2* o8 = (u32x2*)(Hn + (size_t)(m4 + q) * 1024) + lane;
#pragma unroll
                for (int j = 0; j < 4; ++j) { const f32x4 gg = *((const f32x4*)norm_g + lane + 64 * j);
                    o8[64 * j] = (u32x2){pk2(v[q][j][0] * rstd * gg[0], v[q][j][1] * rstd * gg[1]), pk2(v[q][j][2] * rstd * gg[2], v[q][j][3] * rstd * gg[3])}; }
            }
        }
        __syncthreads();
    }
    SEAM(0);
    if (IN(1)) {
        pg8::Gemm g{Hn, Wt_in, M_TOK, 10240, 1024}; pg8::SegOrder S; S.init(G, bid, 0);
        EpiA E{SBQ, SBK, SBV, HGQ, HGI, Gf, lb_logits};
        pg8::gemm_phase<EpiA, pg8::SegOrder, true, true>(lds, g, S, E);
    }
    SEAM(1);
    const bool scan_in_p2 = (G == 256);
    unsigned* cntA = (unsigned*)(ws + 65536);
    if (IN(2)) {
        for (int u = bid; u < 512; u += G) hg_unit_a(lds, u, Gf, HGI, ST, DG, scan_in_p2 ? cntA : nullptr);
        __syncthreads();
        for (int u = bid; u < 1024; u += G) sb_unit(lds, u, SBQ, SBK, SBV);
        __syncthreads();
        if (scan_in_p2) {
            grp_wait(cntA + 64 * (bid >> 5), 32u); grp_wait(cntA + 64 * ((bid >> 5) + 8), 32u);
#pragma unroll
            for (int j = 0; j < 2; ++j) {
                const int bh = (bid >> 5) + 8 * j;
                const int kv = (bid & 31) * 512 + tid, k = kv >> 7;
                float* stp = ST + ((size_t)(bh * 32) << 14) + kv;
                const float* dgp = DG + (bh * 32) * 128 + k;
                float u[32], d[32];
#pragma unroll
                for (int c = 0; c < 32; ++c) { u[c] = stp[(size_t)c << 14]; d[c] = dgp[c * 128]; }
                float S = 0.f;
#pragma unroll
                for (int c = 0; c < 32; ++c) { stp[(size_t)c << 14] = S; S = d[c] * S + u[c]; }
            }
        }
    }
    SEAM(2);
    if (IN(3) && !scan_in_p2) {
        for (int e = bid * 512 + tid; e < 16 * 16384; e += G * 512) {
            const int bh = e >> 14, kv = e & 16383, k = kv >> 7;
            float* stp = ST + ((size_t)(bh * 32) << 14) + kv;
            const float* dgp = DG + (bh * 32) * 128 + k;
            float u[32], d[32];
#pragma unroll
            for (int c = 0; c < 32; ++c) { u[c] = stp[(size_t)c << 14]; d[c] = dgp[c * 128]; }
            float S = 0.f;
#pragma unroll
            for (int c = 0; c < 32; ++c) { stp[(size_t)c << 14] = S; S = d[c] * S + u[c]; }
        }
    }
    if (IN(3) && IN(4) && !scan_in_p2) xcd_barrier(bar);
    if (IN(4)) {
        {
            LAS float* scr = (LAS float*)(lds + wave * 16384);
            const int gw = bid * 8 + wave, NGW = G * 8;
            for (int it = gw; it < 16 * 128 + 3 * 512; it += NGW) {
                int r = it;
                if (r < 16 * 128) { const int kb = r / 128, j = r % 128, sg = j >> 5, seg = sg == 0 ? 3 : sg + 6; p0_transpose_kn(w_in, 1024, 10240, Wt_in, 0, scr, kb, seg * 32 + (j & 31), lane); continue; } r -= 16 * 128;
                if (r < 512) { p0_transpose_kn(w_sb, 1024, 1024, Wt_sbhg, 0, scr, r / 32, r % 32, lane); continue; } r -= 512;
                if (r < 512) { p0_transpose_kn(w_hg, 1024, 1024, Wt_sbhg, 1024, scr, r / 32, r % 32, lane); continue; } r -= 512;
                p0_transpose_kn(w_out, 1024, 1024, Wt_out, 0, scr, r / 32, r % 32, lane);
            }
            __syncthreads();
        }
        for (int u = bid; u < 512; u += G) hg_unit_c(lds, u, Gf, HGQ, HGI, ST, hg_norm_g);
        __syncthreads();
    }
    SEAM(4);
    if (IN(5)) {
        pg8::Gemm g{Hn, Wt_in, M_TOK, 10240, 1024}; pg8::SegOrder S; S.init(G, bid, 1);
        EpiB E{SBQ, HGQ, GATES, b_gate};
        pg8::gemm_phase<EpiB, pg8::SegOrder, true, true>(lds, g, S, E);
    }
    SEAM(5);
    if (IN(6)) {
        pg8::Gemm g{SBQ, Wt_sbhg, 2 * M_TOK, 2048, 1024}; pg8::PairOrder S; S.init(G, bid);
        EpiC E{GATES, out, Y};
        pg8::gemm_phase<EpiC, pg8::PairOrder, true, true>(lds, g, S, E);
    }
    SEAM(6);
    if (IN(7)) {
        pg8::Gemm g{Y, Wt_out, M_TOK, 1024, 1024}; pg8::PlainOrder S; S.init(M_TOK, 1024, G, bid);
        EpiD E{x, out, fng, (float*)(ws + 131072), (unsigned*)(ws + 16384)};
        pg8::gemm_phase<EpiD, pg8::PlainOrder, true, true>(lds, g, S, E);
    }
#undef IN
#undef SEAM
}

#ifndef MK_N_LAUNCHES
#define MK_N_LAUNCHES 1
#endif
extern "C" void kernel_launch(void* const* d_in, const int* in_sizes, int n_in, void* d_out, int out_size, void* d_ws, size_t ws_size, hipStream_t stream) {
    static int grid = 0;
    if (grid == 0) {
        if (n_in != 10 || out_size != M_TOK * DM || ws_size < WS_END) { fprintf(stderr, "kernel_launch: unexpected shapes (n_in %d out %d ws %zu)\n", n_in, out_size, ws_size); grid = -1; return; }
        int dev = 0, cus = 0, per_cu = 0;
        (void)hipGetDevice(&dev);
        (void)hipDeviceGetAttribute(&cus, hipDeviceAttributeMultiprocessorCount, dev);
        if (hipFuncSetAttribute((const void*)mk_fwd, hipFuncAttributeMaxDynamicSharedMemorySize, LDS_BYTES) != hipSuccess) { fprintf(stderr, "kernel_launch: hipFuncSetAttribute failed\n"); grid = -1; return; }
        if (hipOccupancyMaxActiveBlocksPerMultiprocessor(&per_cu, (const void*)mk_fwd, 512, LDS_BYTES) != hipSuccess || per_cu < 1) { fprintf(stderr, "kernel_launch: occupancy query says %d\n", per_cu); per_cu = 1; }
        (void)hipGetLastError();
        grid = cus > 0 ? cus : 256;
    }
    if (grid < 0) return;
    if (hipMemsetAsync(d_ws, 0, 65536 + 4096, stream) != hipSuccess) { fprintf(stderr, "kernel_launch: memset failed\n"); return; }
    Args a{};
    for (int i = 0; i < 10; ++i) a.in[i] = (const float*)d_in[i];
    a.out = (float*)d_out; a.ws = (unsigned char*)d_ws;
#if MK_N_LAUNCHES == 1
    a.ph_lo = 0; a.ph_hi = 8;
    void* kargs[] = {&a};
    hipError_t e = hipLaunchCooperativeKernel((const void*)mk_fwd, dim3(grid), dim3(512), kargs, LDS_BYTES, stream);
    if (e != hipSuccess) fprintf(stderr, "kernel_launch: cooperative launch failed: %s (grid %d)\n", hipGetErrorString(e), grid);
#else
    for (int p = 0; p < 8; ++p) { a.ph_lo = p; a.ph_hi = p + 1; hipLaunchKernelGGL(mk_fwd, dim3(grid), dim3(512), LDS_BYTES, stream, a); }
#endif
}
```

```cpp
#include <hip/hip_runtime.h>
#include <hip/hip_cooperative_groups.h>
#include <cstdio>
#include <cstdint>
namespace cg = cooperative_groups;

#define LAS __attribute__((address_space(3)))
typedef unsigned short bf16_t;
typedef short bf16x8 __attribute__((ext_vector_type(8)));
typedef float f32x4 __attribute__((ext_vector_type(4)));
typedef unsigned u32x4 __attribute__((ext_vector_type(4)));
typedef unsigned u32x2 __attribute__((ext_vector_type(2)));

namespace pg8 {
constexpr int BM = 256, BK = 64, HALF = 128, HTB = HALF * BK * 2, STAGE_BYTES = 8 * HTB, NXCD = 8, WGM = 8;
__host__ __device__ __forceinline__ int lds_byte(int r, int c) { const int st = (r >> 4) * 2 + (c >> 5), rr = r & 15, cc = c & 31, ob = rr * 64 + cc * 2; return st * 1024 + (ob ^ (((ob >> 9) & 1) << 5)); }
__host__ __device__ __forceinline__ void stage_rc(int b, int& R, int& C) { const int st = b / 1024, sb = b % 1024, swz = sb ^ (((sb >> 9) & 1) << 5); R = (st >> 1) * 16 + swz / 64; C = (st & 1) * 32 + (swz % 64) / 2; }
__host__ __device__ __forceinline__ int perm32(int rho) { const int n = rho >> 4, i = rho & 15; return 8 * (i >> 2) + 4 * n + (i & 3); }

struct Unit { int pm, pn; };
struct Gemm { const bf16_t* A; const bf16_t* Bt; int M, N, K; };

struct StaticOrder {
    int nM, nN, nwg, G, c;
    __host__ __device__ void init(int M, int N, int G_, int c_) { nM = M / BM; nN = N / BM; nwg = nM * nN; G = G_; c = c_; }
    __host__ __device__ bool next(int i, Unit& u) const {
        const long L = (long)i * G + c; if (L >= nwg) return false;
        int wgid = (int)L; { const int q = nwg / NXCD, r = nwg % NXCD, xcd = wgid % NXCD, off = wgid / NXCD; wgid = (xcd < r ? xcd * (q + 1) : r * (q + 1) + (xcd - r) * q) + off; }
        const int nig = WGM * nN, gid = wgid / nig, fm = gid * WGM, gsz = (nM - fm) < WGM ? (nM - fm) : WGM;
        u.pm = fm + ((wgid % nig) % gsz); u.pn = (wgid % nig) / gsz; return true;
    }
};
struct SegOrder {
    StaticOrder so; int mode;
    __device__ void init(int G, int c, int mode_) { mode = mode_; so.init(16384, (mode_ == 0 ? 24 : 16) * 256, G, c); }
    __device__ bool next(int i, Unit& u) const {
        if (!so.next(i, u)) return false;
        if (mode == 0) u.pn = (u.pn < 12) ? u.pn : u.pn + 4; else u.pn = (u.pn < 4) ? u.pn + 12 : u.pn + 24;
        return true;
    }
    __device__ __forceinline__ void a_ready(const Unit&) const {}
    __device__ __forceinline__ void done(const Unit&) const {}
};
struct PairOrder {
    StaticOrder so;
    __device__ void init(int G, int c) { so.init(16384, 1024, G, c); }
    __device__ bool next(int i, Unit& u) const { if (!so.next(i >> 1, u)) return false; u.pm += 64 * (i & 1); u.pn += 4 * (i & 1); return true; }
    __device__ __forceinline__ void a_ready(const Unit&) const {}
    __device__ __forceinline__ void done(const Unit&) const {}
};
struct PlainOrder {
    StaticOrder so;
    __device__ void init(int M, int N, int G, int c) { so.init(M, N, G, c); }
    __device__ bool next(int i, Unit& u) const { return so.next(i, u); }
    __device__ __forceinline__ void a_ready(const Unit&) const {}
    __device__ __forceinline__ void done(const Unit&) const {}
};

typedef float f32x2_t __attribute__((ext_vector_type(2)));
typedef __bf16 bf16x2_t __attribute__((ext_vector_type(2)));
__device__ __forceinline__ unsigned cvt_pk_bf16(float lo, float hi) { f32x2_t v = {lo, hi}; bf16x2_t b = __builtin_convertvector(v, bf16x2_t); return __builtin_bit_cast(unsigned, b); }

template <class Epi, class Sched, bool ALIGN_EPI = false, bool SP2 = false>
__device__ __forceinline__ void gemm_phase(LAS unsigned char* lds, const Gemm g, const Sched& S, const Epi& E) {
    const int tid = threadIdx.x, wid = __builtin_amdgcn_readfirstlane(tid >> 6), lane = tid & 63, wr = wid >> 2, wc = wid & 3, fr = lane & 15, fq = lane >> 4;
    const int K = g.K, nt = K / BK;
    unsigned voffA[2], voffB[2];
#pragma unroll
    for (int i = 0; i < 2; ++i) { int R, C; stage_rc(tid * 16 + i * 8192, R, C); const int Rb = Epi::PERM ? ((R & ~31) + perm32(R & 31)) : R;
        voffA[i] = (unsigned)(R * K + C) * 2u; voffB[i] = (unsigned)(Rb * K + C) * 2u; }
    const size_t kstep = (size_t)(BK * 2);
    const size_t hstep = (size_t)HALF * K * 2;
    const size_t tstep = 2 * hstep;
    const unsigned ldsw = (unsigned)wid * 1024u;
    const int aoff = lds_byte(wr * 64 + fr, fq * 8), boff = lds_byte(wc * 32 + fr, fq * 8);
#define PG8_SA(b, h) (((b) * 2 + (h)) * HTB)
#define PG8_SB(b, h) ((4 + (b) * 2 + (h)) * HTB)
#define PG8_STAGE(bufoff, gbase, voff) do { _Pragma("unroll") for (int _i = 0; _i < 2; ++_i) \
        __builtin_amdgcn_global_load_lds((const unsigned*)((const char*)(gbase) + (voff)[_i]), (LAS unsigned*)(lds + (bufoff) + ldsw + _i * 8192), 16, 0, 0); } while (0)
#define PG8_LDA(dst, b, h) do { _Pragma("unroll") for (int m = 0; m < 4; ++m) _Pragma("unroll") for (int k = 0; k < 2; ++k) dst[m][k] = *(const LAS bf16x8*)(lds + PG8_SA(b, h) + aoff + m * 2048 + k * 1024); } while (0)
#define PG8_LDB(dst, b, h) do { _Pragma("unroll") for (int n = 0; n < 2; ++n) _Pragma("unroll") for (int k = 0; k < 2; ++k) dst[n][k] = *(const LAS bf16x8*)(lds + PG8_SB(b, h) + boff + n * 2048 + k * 1024); } while (0)
#define PG8_MMA(ai, bj, At, Bt) do { __builtin_amdgcn_s_setprio(1); _Pragma("unroll") for (int m = 0; m < 4; ++m) _Pragma("unroll") for (int n = 0; n < 2; ++n) _Pragma("unroll") for (int k = 0; k < 2; ++k) \
        acc[ai][bj][m][n] = __builtin_amdgcn_mfma_f32_16x16x32_bf16(Bt[n][k], At[m][k], acc[ai][bj][m][n], 0, 0, 0); __builtin_amdgcn_s_setprio(0); } while (0)
#define PG8_WAIT_V(n) asm volatile("s_waitcnt vmcnt(" #n ")" ::: "memory")
#define PG8_WAIT_L(n) asm volatile("s_waitcnt lgkmcnt(" #n ")" ::: "memory")
#define PG8_BAR __builtin_amdgcn_s_barrier()
#define PG8_SCHED __builtin_amdgcn_sched_barrier(0)
    Unit cur, nxt; int ui = 0;
    if (!S.next(0, cur)) return;
    f32x4 acc[2][2][4][2];
#pragma unroll
    for (int a = 0; a < 2; ++a)
#pragma unroll
        for (int b = 0; b < 2; ++b)
#pragma unroll
            for (int m = 0; m < 4; ++m)
#pragma unroll
                for (int n = 0; n < 2; ++n) acc[a][b][m][n] = (f32x4){0.f, 0.f, 0.f, 0.f};
    bf16x8 At[4][2], B0[2][2], B1[2][2];
    const char* cA = (const char*)g.A + (size_t)cur.pm * tstep; const char* cB = (const char*)g.Bt + (size_t)cur.pn * tstep;
    S.a_ready(cur);
    if constexpr (SP2) {
        PG8_STAGE(PG8_SB(0, 0), cB, voffB); PG8_STAGE(PG8_SB(0, 1), cB + hstep, voffB); PG8_STAGE(PG8_SA(0, 0), cA, voffA); PG8_STAGE(PG8_SA(0, 1), cA + hstep, voffA);
        if (wr == 1) PG8_BAR;
        PG8_WAIT_V(2); PG8_BAR;
        PG8_STAGE(PG8_SB(1, 0), cB + kstep, voffB); PG8_STAGE(PG8_SA(1, 0), cA + kstep, voffA); PG8_STAGE(PG8_SB(1, 1), cB + hstep + kstep, voffB);
        PG8_WAIT_V(6); PG8_BAR;
    } else {
        PG8_STAGE(PG8_SB(0, 0), cB, voffB); PG8_STAGE(PG8_SA(0, 0), cA, voffA); PG8_STAGE(PG8_SB(0, 1), cB + hstep, voffB); PG8_STAGE(PG8_SA(0, 1), cA + hstep, voffA);
        if (wr == 1) PG8_BAR;
        PG8_WAIT_V(4); PG8_BAR;
        PG8_STAGE(PG8_SB(1, 0), cB + kstep, voffB); PG8_STAGE(PG8_SA(1, 0), cA + kstep, voffA); PG8_STAGE(PG8_SB(1, 1), cB + hstep + kstep, voffB);
        PG8_WAIT_V(6); PG8_BAR;
    }
    for (;;) {
        const bool has_next = S.next(ui + 1, nxt);
        const char* nA = has_next ? (const char*)g.A + (size_t)nxt.pm * tstep : cA; const char* nB = has_next ? (const char*)g.Bt + (size_t)nxt.pn * tstep : cB;
        for (int t = 0; t < nt; t += 2) {
            const bool last = (t == nt - 2);
            const char* a1 = cA + (size_t)(t + 1) * kstep;
            const char* a2 = last ? nA : cA + (size_t)(t + 2) * kstep; const char* b2 = last ? nB : cB + (size_t)(t + 2) * kstep;
            const char* a3 = a2 + kstep; const char* b3 = b2 + kstep;
            if (last && has_next) S.a_ready(nxt);
            if constexpr (SP2) {
            PG8_LDB(B0, 0, 0); PG8_LDB(B1, 0, 1); PG8_SCHED; PG8_LDA(At, 0, 0); PG8_STAGE(PG8_SA(1, 1), a1 + hstep, voffA);
            PG8_WAIT_V(8); PG8_WAIT_L(0); PG8_BAR; PG8_MMA(0, 0, At, B0); PG8_MMA(0, 1, At, B1); PG8_BAR; PG8_SCHED;
            PG8_LDA(At, 0, 1); PG8_STAGE(PG8_SB(0, 0), b2, voffB); PG8_STAGE(PG8_SB(0, 1), b2 + hstep, voffB); PG8_STAGE(PG8_SA(0, 0), a2, voffA);
            PG8_WAIT_V(8); PG8_WAIT_L(0); PG8_BAR; PG8_MMA(1, 0, At, B0); PG8_MMA(1, 1, At, B1); PG8_BAR; PG8_SCHED;
            PG8_LDB(B0, 1, 0); PG8_LDB(B1, 1, 1); PG8_SCHED; PG8_LDA(At, 1, 0); PG8_STAGE(PG8_SA(0, 1), a2 + hstep, voffA);
            PG8_WAIT_V(8); PG8_WAIT_L(0); PG8_BAR; PG8_MMA(0, 0, At, B0); PG8_MMA(0, 1, At, B1); PG8_BAR; PG8_SCHED;
            PG8_LDA(At, 1, 1); PG8_STAGE(PG8_SB(1, 0), b3, voffB); PG8_STAGE(PG8_SB(1, 1), b3 + hstep, voffB); PG8_STAGE(PG8_SA(1, 0), a3, voffA);
            PG8_WAIT_V(8); PG8_WAIT_L(0); PG8_BAR; PG8_MMA(1, 0, At, B0); PG8_MMA(1, 1, At, B1); PG8_BAR; PG8_SCHED;
            } else {
            PG8_LDB(B0, 0, 0); PG8_SCHED; PG8_LDA(At, 0, 0); PG8_STAGE(PG8_SA(1, 1), a1 + hstep, voffA);
            PG8_WAIT_L(8); PG8_BAR; PG8_WAIT_L(0); PG8_MMA(0, 0, At, B0); PG8_BAR; PG8_SCHED;
            PG8_LDB(B1, 0, 1); PG8_STAGE(PG8_SB(0, 0), b2, voffB);
            PG8_BAR; PG8_WAIT_L(0); PG8_MMA(0, 1, At, B1); PG8_BAR;
            PG8_LDA(At, 0, 1); PG8_STAGE(PG8_SA(0, 0), a2, voffA);
            PG8_BAR; PG8_WAIT_L(0); PG8_MMA(1, 0, At, B0); PG8_BAR; PG8_SCHED;
            PG8_STAGE(PG8_SB(0, 1), b2 + hstep, voffB);
            PG8_WAIT_V(6); PG8_BAR; PG8_MMA(1, 1, At, B1); PG8_BAR;
            PG8_LDB(B0, 1, 0); PG8_SCHED; PG8_LDA(At, 1, 0); PG8_STAGE(PG8_SA(0, 1), a2 + hstep, voffA);
            PG8_WAIT_L(8); PG8_BAR; PG8_WAIT_L(0); PG8_MMA(0, 0, At, B0); PG8_BAR; PG8_SCHED;
            PG8_LDB(B1, 1, 1); PG8_STAGE(PG8_SB(1, 0), b3, voffB);
            PG8_BAR; PG8_WAIT_L(0); PG8_MMA(0, 1, At, B1); PG8_BAR;
            PG8_LDA(At, 1, 1); PG8_STAGE(PG8_SA(1, 0), a3, voffA);
            PG8_BAR; PG8_WAIT_L(0); PG8_MMA(1, 0, At, B0); PG8_BAR; PG8_SCHED;
            PG8_STAGE(PG8_SB(1, 1), b3 + hstep, voffB);
            PG8_WAIT_V(6); PG8_BAR; PG8_MMA(1, 1, At, B1); PG8_BAR;
            }
        }
        if constexpr (ALIGN_EPI) { if (wr == 0) PG8_BAR; }
        if constexpr (!Epi::AFTER_DRAIN) { E(acc, cur, wr, wc, fr, fq); S.done(cur); }
        if (!has_next) break;
#pragma unroll
        for (int a = 0; a < 2; ++a)
#pragma unroll
            for (int b = 0; b < 2; ++b)
#pragma unroll
                for (int m = 0; m < 4; ++m)
#pragma unroll
                    for (int n = 0; n < 2; ++n) acc[a][b][m][n] = (f32x4){0.f, 0.f, 0.f, 0.f};
        cur = nxt; cA = nA; cB = nB; ++ui;
        if constexpr (ALIGN_EPI) { if (wr == 1) PG8_BAR; }
    }
    PG8_WAIT_V(0);
    if constexpr (!ALIGN_EPI) { if (wr == 0) PG8_BAR; }
    PG8_BAR;
    if constexpr (Epi::AFTER_DRAIN) { E.fused(acc, cur, wr, wc, fr, fq, lds, wid, lane); S.done(cur); }
#undef PG8_SA
#undef PG8_SB
#undef PG8_STAGE
#undef PG8_LDA
#undef PG8_LDB
#undef PG8_MMA
#undef PG8_WAIT_V
#undef PG8_WAIT_L
#undef PG8_BAR
#undef PG8_SCHED
}
}
using pg8::cvt_pk_bf16;

constexpr int M_TOK = 16384, DM = 1024, SEQ = 8192;
constexpr size_t MiB = 1u << 20;
constexpr size_t WS_ROWSQ = 128 * 1024;
constexpr size_t WS_WIN = 1 * MiB;
constexpr size_t WS_WSBHG = 21 * MiB;
constexpr size_t WS_WOUT = 25 * MiB;
constexpr size_t WS_HGD = 27 * MiB;
constexpr size_t WS_H = 28 * MiB;
constexpr size_t WS_SBQ = 60 * MiB;
constexpr size_t WS_HGQ = 92 * MiB;
constexpr size_t WS_SBK = 124 * MiB;
constexpr size_t WS_SBV = 156 * MiB;
constexpr size_t WS_HGI = 188 * MiB;
constexpr size_t WS_ST = 220 * MiB;
constexpr size_t WS_GATES = 124 * MiB;
constexpr size_t WS_Y = 188 * MiB;
constexpr size_t WS_END = 252 * MiB;
constexpr int LDS_BYTES = 163840, LDS_MISC = 163840 - 64;
constexpr float RMS_EPS = 1e-6f;

__device__ __forceinline__ float bf2f(unsigned u) { return __uint_as_float(u << 16); }
__device__ __forceinline__ unsigned f2bf(float f) { unsigned u = __float_as_uint(f); return (u + 0x7fffu + ((u >> 16) & 1u)) >> 16; }
__device__ __forceinline__ unsigned pk2(float lo, float hi) { return f2bf(lo) | (f2bf(hi) << 16); }
__device__ __forceinline__ float sigmoidf_(float v) { return __builtin_amdgcn_rcpf(1.f + __expf(-v)); }
__device__ __forceinline__ float siluf_(float v) { return v * sigmoidf_(v); }
__device__ __forceinline__ float wave_sum(float v) {
#pragma unroll
    for (int o = 1; o < 64; o <<= 1) v += __shfl_xor(v, o);
    return v;
}

struct EpiA {
    static constexpr bool AFTER_DRAIN = false;
    static constexpr bool PERM = true;
    bf16_t* sbq; bf16_t* sbk; bf16_t* sbv; bf16_t* hgq; bf16_t* hgi; float* G; const float* lbl;
    __device__ __forceinline__ void operator()(const f32x4 (&acc)[2][2][4][2], const pg8::Unit& u, int wr, int wc, int fr, int fq) const {
        const int seg = u.pn >> 2;
        const int row0 = u.pm * 256 + wr * 64 + fr, col0 = (u.pn & 3) * 256 + wc * 32 + 8 * fq;
        if (seg == 5) {
#pragma unroll
            for (int bj = 0; bj < 2; ++bj) {
                const int col = col0 + bj * 128;
                float lb[8];
#pragma unroll
                for (int j = 0; j < 8; ++j) lb[j] = __builtin_amdgcn_rcpf(1.f + __expf(lbl[1024 + col + j] - lbl[col + j]));
#pragma unroll
                for (int ai = 0; ai < 2; ++ai)
#pragma unroll
                    for (int m = 0; m < 4; ++m) {
                        bf16_t* p = (bf16_t*)G + (size_t)(row0 + ai * 128 + m * 16) * 1024 + col;
                        f32x4 a = acc[ai][bj][m][0], b = acc[ai][bj][m][1], ga, gb;
#pragma unroll
                        for (int j = 0; j < 4; ++j) { ga[j] = __logf(lb[j] + (1.f - lb[j]) * sigmoidf_(a[j])); gb[j] = __logf(lb[4 + j] + (1.f - lb[4 + j]) * sigmoidf_(b[j])); }
                        u32x4 w; w.x = cvt_pk_bf16(ga[0], ga[1]); w.y = cvt_pk_bf16(ga[2], ga[3]); w.z = cvt_pk_bf16(gb[0], gb[1]); w.w = cvt_pk_bf16(gb[2], gb[3]);
                        *(u32x4*)p = w;
                    }
            }
        } else {
            if (seg == 2) {
#pragma unroll
                for (int ai = 0; ai < 2; ++ai)
#pragma unroll
                    for (int m = 0; m < 4; ++m) {
                        const int row = row0 + ai * 128 + m * 16, bb = row >> 13, ss = row & 8191;
#pragma unroll
                        for (int bj = 0; bj < 2; ++bj) {
                            const int col = col0 + bj * 128;
                            bf16_t* p = sbv + ((size_t)(bb * 1024 + col)) * 8192 + ss;
                            const f32x4 a = acc[ai][bj][m][0], b = acc[ai][bj][m][1];
#pragma unroll
                            for (int j = 0; j < 4; ++j) { p[(size_t)j * 8192] = (bf16_t)f2bf(a[j]); p[(size_t)(4 + j) * 8192] = (bf16_t)f2bf(b[j]); }
                        }
                    }
                return;
            }
            bf16_t* base = seg == 0 ? sbq : seg == 1 ? sbk : seg == 2 ? sbv : seg == 4 ? hgq : hgi;
            const float sc = seg == 0 ? 0.08838834764831845f : 1.f; const bool act = seg == 4;
#pragma unroll
            for (int ai = 0; ai < 2; ++ai)
#pragma unroll
                for (int m = 0; m < 4; ++m)
#pragma unroll
                    for (int bj = 0; bj < 2; ++bj) {
                        f32x4 a = acc[ai][bj][m][0], b = acc[ai][bj][m][1];
                        if (act) {
#pragma unroll
                            for (int j = 0; j < 4; ++j) { a[j] = siluf_(a[j]); b[j] = siluf_(b[j]); } }
                        a = a * sc; b = b * sc;
                        u32x4 w; w.x = cvt_pk_bf16(a[0], a[1]); w.y = cvt_pk_bf16(a[2], a[3]); w.z = cvt_pk_bf16(b[0], b[1]); w.w = cvt_pk_bf16(b[2], b[3]);
                        *(u32x4*)(base + (size_t)(row0 + ai * 128 + m * 16) * 1024 + col0 + bj * 128) = w;
                    }
        }
    }
};
struct EpiB {
    static constexpr bool AFTER_DRAIN = false;
    static constexpr bool PERM = true;
    bf16_t* asb; bf16_t* ahg; bf16_t* gates; const float* bgate;
    __device__ __forceinline__ void operator()(const f32x4 (&acc)[2][2][4][2], const pg8::Unit& u, int wr, int wc, int fr, int fq) const {
        const int seg = u.pn >> 2;
        const int row0 = u.pm * 256 + wr * 64 + fr, col0 = (u.pn & 3) * 256 + wc * 32 + 8 * fq;
        if (seg >= 8) {
#pragma unroll
            for (int bj = 0; bj < 2; ++bj) {
                const int col = (seg - 8) * 1024 + col0 + bj * 128;
                const f32x4 b0 = *(const f32x4*)(bgate + col), b1 = *(const f32x4*)(bgate + col + 4);
#pragma unroll
                for (int ai = 0; ai < 2; ++ai)
#pragma unroll
                    for (int m = 0; m < 4; ++m) {
                        f32x4 a = acc[ai][bj][m][0] + b0, b = acc[ai][bj][m][1] + b1;
#pragma unroll
                        for (int j = 0; j < 4; ++j) { a[j] = sigmoidf_(a[j]); b[j] = sigmoidf_(b[j]); }
                        u32x4 w; w.x = cvt_pk_bf16(a[0], a[1]); w.y = cvt_pk_bf16(a[2], a[3]); w.z = cvt_pk_bf16(b[0], b[1]); w.w = cvt_pk_bf16(b[2], b[3]);
                        *(u32x4*)(gates + (size_t)(row0 + ai * 128 + m * 16) * 2048 + col) = w;
                    }
            }
        } else {
            bf16_t* base = seg == 3 ? asb : ahg;
#pragma unroll
            for (int ai = 0; ai < 2; ++ai) {
                u32x4 ov[4][2];
#pragma unroll
                for (int m = 0; m < 4; ++m)
#pragma unroll
                    for (int bj = 0; bj < 2; ++bj) ov[m][bj] = *(const u32x4*)(base + (size_t)(row0 + ai * 128 + m * 16) * 1024 + col0 + bj * 128);
#pragma unroll
                for (int m = 0; m < 4; ++m)
#pragma unroll
                    for (int bj = 0; bj < 2; ++bj) {
                        const u32x4 o = ov[m][bj];
                        const f32x4 a = acc[ai][bj][m][0], b = acc[ai][bj][m][1];
                        u32x4 w;
                        w.x = cvt_pk_bf16(bf2f(o.x & 0xffffu) * siluf_(a[0]), bf2f(o.x >> 16) * siluf_(a[1]));
                        w.y = cvt_pk_bf16(bf2f(o.y & 0xffffu) * siluf_(a[2]), bf2f(o.y >> 16) * siluf_(a[3]));
                        w.z = cvt_pk_bf16(bf2f(o.z & 0xffffu) * siluf_(b[0]), bf2f(o.z >> 16) * siluf_(b[1]));
                        w.w = cvt_pk_bf16(bf2f(o.w & 0xffffu) * siluf_(b[2]), bf2f(o.w >> 16) * siluf_(b[3]));
                        *(u32x4*)(base + (size_t)(row0 + ai * 128 + m * 16) * 1024 + col0 + bj * 128) = w;
                    }
            }
        }
    }
};
struct EpiC {
    static constexpr bool AFTER_DRAIN = false;
    static constexpr bool PERM = true;
    const bf16_t* gates; float* tmp; bf16_t* Y;
    __device__ __forceinline__ void operator()(const f32x4 (&acc)[2][2][4][2], const pg8::Unit& u, int wr, int wc, int fr, int fq) const {
        const bool second = u.pm >= 64;
        const int pm = second ? u.pm - 64 : u.pm, pn = second ? u.pn - 4 : u.pn;
        const int row0 = pm * 256 + wr * 64 + fr, col0 = pn * 256 + wc * 32 + 8 * fq;
#pragma unroll
        for (int ai = 0; ai < 2; ++ai)
#pragma unroll
        for (int mh = 0; mh < 2; ++mh) {
            u32x4 gv[2][2], tv[2][2];
#pragma unroll
            for (int mm = 0; mm < 2; ++mm)
#pragma unroll
                for (int bj = 0; bj < 2; ++bj) {
                    const size_t row = (size_t)(row0 + ai * 128 + (2 * mh + mm) * 16); const int col = col0 + bj * 128;
                    gv[mm][bj] = *(const u32x4*)(gates + row * 2048 + (second ? 1024 : 0) + col);
                    if (second) tv[mm][bj] = *(const u32x4*)((const bf16_t*)tmp + row * 1024 + col);
                }
#pragma unroll
            for (int mm = 0; mm < 2; ++mm)
#pragma unroll
                for (int bj = 0; bj < 2; ++bj) {
                    const int m = 2 * mh + mm;
                    const size_t row = (size_t)(row0 + ai * 128 + m * 16); const int col = col0 + bj * 128;
                    const u32x4 gt = gv[mm][bj];
                    f32x4 a = acc[ai][bj][m][0], b = acc[ai][bj][m][1];
                    a[0] *= bf2f(gt.x & 0xffffu); a[1] *= bf2f(gt.x >> 16); a[2] *= bf2f(gt.y & 0xffffu); a[3] *= bf2f(gt.y >> 16);
                    b[0] *= bf2f(gt.z & 0xffffu); b[1] *= bf2f(gt.z >> 16); b[2] *= bf2f(gt.w & 0xffffu); b[3] *= bf2f(gt.w >> 16);
                    if (!second) { u32x4 w; w.x = cvt_pk_bf16(a[0], a[1]); w.y = cvt_pk_bf16(a[2], a[3]); w.z = cvt_pk_bf16(b[0], b[1]); w.w = cvt_pk_bf16(b[2], b[3]); *(u32x4*)((bf16_t*)tmp + row * 1024 + col) = w; }
                    else {
                        { const u32x4 t = tv[mm][bj]; a[0] += bf2f(t.x & 0xffffu); a[1] += bf2f(t.x >> 16); a[2] += bf2f(t.y & 0xffffu); a[3] += bf2f(t.y >> 16);
                          b[0] += bf2f(t.z & 0xffffu); b[1] += bf2f(t.z >> 16); b[2] += bf2f(t.w & 0xffffu); b[3] += bf2f(t.w >> 16); }
                        u32x4 w; w.x = cvt_pk_bf16(a[0], a[1]); w.y = cvt_pk_bf16(a[2], a[3]); w.z = cvt_pk_bf16(b[0], b[1]); w.w = cvt_pk_bf16(b[2], b[3]);
                        *(u32x4*)(Y + row * 1024 + col) = w;
                    }
                }
        }
    }
};
struct EpiD {
    static constexpr bool PERM = true, AFTER_DRAIN = true;
    const float* x; float* out; const float* fng; float* xb; unsigned* cnt;
    __device__ __forceinline__ void operator()(const f32x4 (&)[2][2][4][2], const pg8::Unit&, int, int, int, int) const {}
    __device__ __forceinline__ void fused(f32x4 (&acc)[2][2][4][2], const pg8::Unit& u, int wr, int wc, int fr, int fq, LAS unsigned char* lds, int wid, int lane) const {
        const int tid = threadIdx.x;
        const int row0 = u.pm * 256 + wr * 64 + fr, col0 = u.pn * 256 + wc * 32 + 8 * fq;
        LAS float* P = (LAS float*)lds;
        LAS float* Sr = (LAS float*)(lds + 4096);
#pragma unroll
        for (int ai = 0; ai < 2; ++ai) {
            f32x4 xa[4][2], xc[4][2];
#pragma unroll
            for (int m = 0; m < 4; ++m)
#pragma unroll
                for (int bj = 0; bj < 2; ++bj) {
                    const size_t off = (size_t)(row0 + ai * 128 + m * 16) * 1024 + col0 + bj * 128;
                    xa[m][bj] = *(const f32x4*)(x + off); xc[m][bj] = *(const f32x4*)(x + off + 4);
                }
#pragma unroll
            for (int m = 0; m < 4; ++m) {
                float ss = 0.f;
#pragma unroll
                for (int bj = 0; bj < 2; ++bj) {
                    const f32x4 a = acc[ai][bj][m][0] + xa[m][bj], b = acc[ai][bj][m][1] + xc[m][bj];
                    acc[ai][bj][m][0] = a; acc[ai][bj][m][1] = b;
                    ss += (a[0] * a[0] + a[1] * a[1]) + (a[2] * a[2] + a[3] * a[3]) + (b[0] * b[0] + b[1] * b[1]) + (b[2] * b[2] + b[3] * b[3]);
                }
                ss += __shfl_xor(ss, 16); ss += __shfl_xor(ss, 32);
                if (fq == 0) P[(ai * 128 + wr * 64 + m * 16 + fr) * 4 + wc] = ss;
            }
        }
        __syncthreads();
        if (tid < 256) {
            const float t = (P[tid * 4] + P[tid * 4 + 1]) + (P[tid * 4 + 2] + P[tid * 4 + 3]);
            __hip_atomic_store(xb + ((size_t)(u.pm * 4 + u.pn)) * 256 + tid, t, __ATOMIC_RELAXED, __HIP_MEMORY_SCOPE_AGENT);
        }
        asm volatile("s_waitcnt vmcnt(0)" ::: "memory");
        __syncthreads();
        if (tid == 0) {
            unsigned* c = cnt + 64 * u.pm;
            (void)__hip_atomic_fetch_add(c, 1u, __ATOMIC_RELAXED, __HIP_MEMORY_SCOPE_AGENT);
            unsigned sp = 0;
            while (__hip_atomic_load(c, __ATOMIC_RELAXED, __HIP_MEMORY_SCOPE_AGENT) < 4u) { __builtin_amdgcn_s_sleep(2); if (++sp > (1u << 22)) break; }
            __builtin_amdgcn_fence(__ATOMIC_ACQUIRE, "agent");
            asm volatile("s_waitcnt vmcnt(0)" ::: "memory");
        }
        __syncthreads();
        if (tid < 256) {
            float t = 0.f;
#pragma unroll
            for (int pn = 0; pn < 4; ++pn) t += __hip_atomic_load(xb + ((size_t)(u.pm * 4 + pn)) * 256 + tid, __ATOMIC_RELAXED, __HIP_MEMORY_SCOPE_AGENT);
            Sr[tid] = __builtin_amdgcn_rsqf(t * (1.f / 1024.f) + RMS_EPS);
        }
        __syncthreads();
#pragma unroll
        for (int bj = 0; bj < 2; ++bj) {
            const f32x4 g0 = *(const f32x4*)(fng + col0 + bj * 128), g1 = *(const f32x4*)(fng + col0 + bj * 128 + 4);
#pragma unroll
            for (int ai = 0; ai < 2; ++ai)
#pragma unroll
                for (int m = 0; m < 4; ++m) {
                    const float rstd = Sr[ai * 128 + wr * 64 + m * 16 + fr];
                    const size_t off = (size_t)(row0 + ai * 128 + m * 16) * 1024 + col0 + bj * 128;
                    *(f32x4*)(out + off) = acc[ai][bj][m][0] * rstd * g0; *(f32x4*)(out + off + 4) = acc[ai][bj][m][1] * rstd * g1;
                }
        }
    }
};

__device__ __forceinline__ void p0_transpose_kn(const float* W, int K, int N, bf16_t* WT, int row_off, LAS float* scr, int kb, int nb, int lane) {
    const int k0 = 64 * kb, n0 = 32 * nb;
    float wv[32];
#pragma unroll
    for (int i = 0; i < 32; ++i) wv[i] = W[(size_t)(k0 + 2 * i + (lane >> 5)) * N + n0 + (lane & 31)];
#pragma unroll
    for (int i = 0; i < 32; ++i) scr[(2 * i + (lane >> 5)) * 33 + (lane & 31)] = wv[i];
    asm volatile("s_waitcnt lgkmcnt(0)" ::: "memory");
    const int c = lane & 7;
#pragma unroll
    for (int j = 0; j < 4; ++j) { const int n = (lane >> 3) + 8 * j; const LAS float* s = scr + (8 * c) * 33 + n;
        u32x4 o; o.x = pk2(s[0 * 33], s[1 * 33]); o.y = pk2(s[2 * 33], s[3 * 33]); o.z = pk2(s[4 * 33], s[5 * 33]); o.w = pk2(s[6 * 33], s[7 * 33]);
        *(u32x4*)(WT + (size_t)(row_off + n0 + n) * K + k0 + 8 * c) = o; }
    asm volatile("s_waitcnt lgkmcnt(0)" ::: "memory");
}

constexpr int SB_KW = 0, SB_VW = 69632, SB_ZS = 137216;
__device__ __forceinline__ void sb_unit(LAS unsigned char* lds, int unit, bf16_t* Q, const bf16_t* Kb, const bf16_t* VT) {
    const int tid = threadIdx.x, lane = tid & 63, w = tid >> 6, r = lane & 15, g = lane >> 4;
    const int bh = unit >> 6, qb = unit & 63, b = bh >> 3, h = bh & 7;
    const size_t rowbase = (size_t)b * SEQ;
    const int tblk = qb * 128, kwin0 = tblk >= 128 ? tblk - 128 : 0;
    LAS bf16_t* Kw = (LAS bf16_t*)(lds + SB_KW);
    LAS bf16_t* Vw = (LAS bf16_t*)(lds + SB_VW);
    LAS float* Zs = (LAS float*)(lds + SB_ZS) + w * (16 * 36);
    {
        u32x4 kv[8], vv[8];
#pragma unroll
        for (int i = 0; i < 8; ++i) { const int c = tid + 512 * i, key = c >> 4, dc = c & 15;
            kv[i] = *(const u32x4*)(Kb + (rowbase + kwin0 + key) * 1024 + h * 128 + 8 * dc); }
#pragma unroll
        for (int i = 0; i < 8; ++i) { const int c = tid + 512 * i, row = c >> 5, kc = c & 31;
            vv[i] = *(const u32x4*)(VT + ((size_t)(bh * 128 + row)) * 8192 + kwin0 + 8 * kc); }
        __syncthreads();
#pragma unroll
        for (int i = 0; i < 8; ++i) { const int c = tid + 512 * i, key = c >> 4, dc = c & 15; *(LAS u32x4*)(Kw + key * 136 + 8 * dc) = kv[i]; }
#pragma unroll
        for (int i = 0; i < 8; ++i) { const int c = tid + 512 * i, row = c >> 5, kc = c & 31; *(LAS u32x4*)(Vw + row * 264 + 8 * kc) = vv[i]; }
    }
    const int t0 = tblk + 16 * w;
    bf16x8 qf[4];
    {
        const bf16_t* qrow = Q + (rowbase + t0 + r) * 1024 + h * 128 + 8 * g;
#pragma unroll
        for (int kk = 0; kk < 4; ++kk) qf[kk] = *(const bf16x8*)(qrow + 32 * kk);
    }
    f32x4 o[8];
#pragma unroll
    for (int n = 0; n < 8; ++n) o[n] = (f32x4){0.f, 0.f, 0.f, 0.f};
    float sacc = 0.f;
    const int t_abs = t0 + r;
    const bf16_t* kbase = Kb + (rowbase + r) * 1024 + h * 128 + 8 * g;
    const bf16_t* vbase = VT + ((size_t)(bh * 128 + r)) * 8192 + 8 * g;
    __syncthreads();
    for (int kt = (t0 + 15) >> 5; kt >= 0; --kt) {
        const int key0 = 32 * kt;
        bf16x8 kf[8], vf[8];
        if (key0 >= kwin0) {
            const LAS bf16_t* kp = Kw + (key0 - kwin0 + r) * 136 + 8 * g;
            const LAS bf16_t* vp = Vw + r * 264 + (key0 - kwin0) + 8 * g;
#pragma unroll
            for (int n = 0; n < 2; ++n)
#pragma unroll
                for (int kk = 0; kk < 4; ++kk) kf[4 * n + kk] = *(const LAS bf16x8*)(kp + (16 * n) * 136 + 32 * kk);
#pragma unroll
            for (int n = 0; n < 8; ++n) vf[n] = *(const LAS bf16x8*)(vp + (16 * n) * 264);
        } else {
#pragma unroll
            for (int n = 0; n < 2; ++n)
#pragma unroll
                for (int kk = 0; kk < 4; ++kk) kf[4 * n + kk] = *(const bf16x8*)(kbase + (size_t)(key0 + 16 * n) * 1024 + 32 * kk);
#pragma unroll
            for (int n = 0; n < 8; ++n) vf[n] = *(const bf16x8*)(vbase + (size_t)(16 * n) * 8192 + key0);
        }
#pragma unroll
        for (int n = 0; n < 2; ++n) {
            f32x4 z = (f32x4){0.f, 0.f, 0.f, 0.f};
#pragma unroll
            for (int kk = 0; kk < 4; ++kk) z = __builtin_amdgcn_mfma_f32_16x16x32_bf16(qf[kk], kf[4 * n + kk], z, 0, 0, 0);
#pragma unroll
            for (int rg = 0; rg < 4; ++rg) Zs[(4 * g + rg) * 36 + 16 * n + r] = z[rg];
        }
        __builtin_amdgcn_wave_barrier();
        bf16x8 afr;
        {
            float zz[8], sp[8];
#pragma unroll
            for (int i = 0; i < 2; ++i) { const f32x4 v = *(const LAS f32x4*)(Zs + r * 36 + 8 * g + 4 * i); zz[4 * i] = v[0]; zz[4 * i + 1] = v[1]; zz[4 * i + 2] = v[2]; zz[4 * i + 3] = v[3]; }
            const int j0 = key0 + 8 * g;
            float run = 0.f;
#pragma unroll
            for (int i = 7; i >= 0; --i) {
                const bool valid = (j0 + i) < t_abs;
                const float s = fmaxf(zz[i], 0.f) + __logf(1.f + __expf(-fabsf(zz[i])));
                sp[i] = valid ? s : 0.f; zz[i] = zz[i] - s; run += sp[i];
            }
            const float tot = run;
            const float t1 = __shfl_xor(tot, 16), t2 = __shfl_xor(tot, 32), t3 = __shfl_xor(t1, 32);
            const float after = (g == 0) ? (t1 + t2 + t3) : (g == 1) ? (t2 + t3) : (g == 2) ? t1 : 0.f;
            float sub = after + sacc;
            unsigned pw[4];
#pragma unroll
            for (int i = 3; i >= 0; --i) {
                const bool v1 = (j0 + 2 * i + 1) < t_abs, v0 = (j0 + 2 * i) < t_abs;
                const float w1 = v1 ? __expf(zz[2 * i + 1] - sub) : 0.f; sub += sp[2 * i + 1];
                const float w0 = v0 ? __expf(zz[2 * i] - sub) : 0.f; sub += sp[2 * i];
                pw[i] = cvt_pk_bf16(w0, w1);
            }
            afr = __builtin_bit_cast(bf16x8, ((u32x4){pw[0], pw[1], pw[2], pw[3]}));
            sacc += tot + t1 + t2 + t3;
        }
        __builtin_amdgcn_wave_barrier();
#pragma unroll
        for (int n = 0; n < 8; ++n) o[n] = __builtin_amdgcn_mfma_f32_16x16x32_bf16(afr, vf[n], o[n], 0, 0, 0);
        float mn = sacc;
#pragma unroll
        for (int s = 1; s < 16; s <<= 1) mn = fminf(mn, __shfl_xor(mn, s));
        if (mn > 104.f) break;
    }
#pragma unroll
    for (int n = 0; n < 8; ++n)
#pragma unroll
        for (int rg = 0; rg < 4; ++rg)
            Q[(rowbase + t0 + 4 * g + rg) * 1024 + h * 128 + 16 * n + r] = (bf16_t)f2bf(o[n][rg]);
}

__device__ __forceinline__ void grp_arrive(unsigned* c) {
    asm volatile("s_waitcnt vmcnt(0)" ::: "memory");
    __syncthreads();
    if (threadIdx.x == 0) (void)__hip_atomic_fetch_add(c, 1u, __ATOMIC_RELAXED, __HIP_MEMORY_SCOPE_AGENT);
}
__device__ __forceinline__ void grp_wait(unsigned* c, unsigned target) {
    if (threadIdx.x == 0) {
        unsigned sp = 0;
        while (__hip_atomic_load(c, __ATOMIC_RELAXED, __HIP_MEMORY_SCOPE_AGENT) < target) { __builtin_amdgcn_s_sleep(2); if (++sp > (1u << 22)) break; }
        __builtin_amdgcn_fence(__ATOMIC_ACQUIRE, "agent");
        asm volatile("s_waitcnt vmcnt(0)" ::: "memory");
    }
    __syncthreads();
}

constexpr int HG_QT = 0, HG_KT = 17408, HG_KD = 34816, HG_VT = 53248, HG_AS = 71680, HG_SP = 80896, HG_PT = 115712, HG_DL = 117760, HG_DM = 118272;
struct HgRegs { float gv[16]; unsigned vv[16]; unsigned qv[16]; };
template <bool FULL>
__device__ __forceinline__ void hg_load(HgRegs& R, size_t m0, int h, const float* G, const bf16_t* HQ, const bf16_t* HI) {
    const int tid = threadIdx.x, k = tid & 127, part = tid >> 7;
    const size_t base = (m0 + 16 * part) * 1024 + h * 128 + k;
#pragma unroll
    for (int i = 0; i < 16; ++i) R.gv[i] = bf2f(((const bf16_t*)G)[base + (size_t)i * 1024]);
#pragma unroll
    for (int i = 0; i < 16; ++i) R.vv[i] = HI[base + (size_t)i * 1024];
    if (FULL) {
#pragma unroll
        for (int i = 0; i < 16; ++i) R.qv[i] = HQ[base + (size_t)i * 1024];
    }
}
template <bool FULL>
__device__ __forceinline__ float hg_prep(LAS unsigned char* lds, const HgRegs& R) {
    const int tid = threadIdx.x, k = tid & 127, part = tid >> 7;
    LAS float* ptot = (LAS float*)(lds + HG_PT);
    float gv[16], cs[16];
    float run = 0.f;
#pragma unroll
    for (int i = 0; i < 16; ++i) { gv[i] = R.gv[i]; run += gv[i]; cs[i] = run; }
    ptot[part * 128 + k] = run;
    unsigned vv[16];
#pragma unroll
    for (int i = 0; i < 16; ++i) vv[i] = R.vv[i];
    __syncthreads();
    const float p0 = ptot[k], p1 = ptot[128 + k], p2 = ptot[256 + k], p3 = ptot[384 + k];
    const float off = (part == 0) ? 0.f : (part == 1) ? p0 : (part == 2) ? (p0 + p1) : (p0 + p1 + p2);
    const float last = (p0 + p1) + (p2 + p3), mid = p0 + p1;
    LAS bf16_t* kdT = (LAS bf16_t*)(lds + HG_KD);
    LAS bf16_t* vT = (LAS bf16_t*)(lds + HG_VT);
    unsigned pk[8];
    float kkv[16], em[16];
    const float clm = __expf(last - mid);
#pragma unroll
    for (int i = 0; i < 16; ++i) { kkv[i] = 1.f - __expf(gv[i]); em[i] = __expf((FULL ? mid : last) - (cs[i] + off)); }
#pragma unroll
    for (int i = 0; i < 8; ++i) {
        const float a = kkv[2 * i] * em[2 * i] * (FULL ? clm : 1.f), c = kkv[2 * i + 1] * em[2 * i + 1] * (FULL ? clm : 1.f);
        pk[i] = cvt_pk_bf16(a, c);
    }
    *(LAS u32x4*)(kdT + k * 72 + 16 * part) = (u32x4){pk[0], pk[1], pk[2], pk[3]};
    *(LAS u32x4*)(kdT + k * 72 + 16 * part + 8) = (u32x4){pk[4], pk[5], pk[6], pk[7]};
    *(LAS u32x4*)(vT + k * 72 + 16 * part) = (u32x4){vv[0] | (vv[1] << 16), vv[2] | (vv[3] << 16), vv[4] | (vv[5] << 16), vv[6] | (vv[7] << 16)};
    *(LAS u32x4*)(vT + k * 72 + 16 * part + 8) = (u32x4){vv[8] | (vv[9] << 16), vv[10] | (vv[11] << 16), vv[12] | (vv[13] << 16), vv[14] | (vv[15] << 16)};
    if (FULL) {
        LAS bf16_t* qt = (LAS bf16_t*)(lds + HG_QT);
        LAS bf16_t* kt = (LAS bf16_t*)(lds + HG_KT);
#pragma unroll
        for (int i = 0; i < 16; ++i) {
            const float q = bf2f(R.qv[i]);
            qt[(16 * part + i) * 136 + k] = (bf16_t)f2bf(q * __builtin_amdgcn_rcpf(em[i]));
            kt[(16 * part + i) * 136 + k] = (bf16_t)f2bf(kkv[i] * em[i]);
        }
    }
    if (part == 0) { ((LAS float*)(lds + HG_DL))[k] = __expf(last); if (FULL) ((LAS float*)(lds + HG_DM))[k] = __expf(mid); }
    return last;
}
__device__ __forceinline__ void hg_state_update(LAS unsigned char* lds, f32x4 (&S)[8], int w, int r, int g) {
    const LAS bf16_t* kdT = (const LAS bf16_t*)(lds + HG_KD);
    const LAS bf16_t* vT = (const LAS bf16_t*)(lds + HG_VT);
    const LAS float* dl = (const LAS float*)(lds + HG_DL);
    const bf16x8 b0 = *(const LAS bf16x8*)(vT + (16 * w + r) * 72 + 8 * g), b1 = *(const LAS bf16x8*)(vT + (16 * w + r) * 72 + 32 + 8 * g);
#pragma unroll
    for (int i = 0; i < 8; ++i) {
        const f32x4 d = *(const LAS f32x4*)(dl + 16 * i + 4 * g);
        S[i] = S[i] * d;
        const bf16x8 a0 = *(const LAS bf16x8*)(kdT + (16 * i + r) * 72 + 8 * g), a1 = *(const LAS bf16x8*)(kdT + (16 * i + r) * 72 + 32 + 8 * g);
        S[i] = __builtin_amdgcn_mfma_f32_16x16x32_bf16(a0, b0, S[i], 0, 0, 0);
        S[i] = __builtin_amdgcn_mfma_f32_16x16x32_bf16(a1, b1, S[i], 0, 0, 0);
    }
}
__device__ __forceinline__ void hg_unit_a(LAS unsigned char* lds, int unit, const float* G, const bf16_t* HI, float* ST, float* DG, unsigned* cnt) {
    const int tid = threadIdx.x, lane = tid & 63, w = tid >> 6, r = lane & 15, g = lane >> 4;
    const int bh = unit >> 5, c = unit & 31, b = bh >> 3, h = bh & 7;
    f32x4 S[8];
#pragma unroll
    for (int i = 0; i < 8; ++i) S[i] = (f32x4){0.f, 0.f, 0.f, 0.f};
    float cumtot = 0.f;
    HgRegs R;
    const size_t mu = (size_t)b * SEQ + c * 256;
    hg_load<false>(R, mu, h, G, nullptr, HI);
    for (int sc = 0; sc < 4; ++sc) {
        __syncthreads();
        cumtot += hg_prep<false>(lds, R);
        if (sc < 3) hg_load<false>(R, mu + (sc + 1) * 64, h, G, nullptr, HI);
        __syncthreads();
        hg_state_update(lds, S, w, r, g);
    }
    float* U = ST + (size_t)unit * 16384;
#pragma unroll
    for (int i = 0; i < 8; ++i)
#pragma unroll
        for (int rg = 0; rg < 4; ++rg) __hip_atomic_store(&U[(16 * i + 4 * g + rg) * 128 + 16 * w + r], S[i][rg], __ATOMIC_RELAXED, __HIP_MEMORY_SCOPE_AGENT);
    if (tid < 128) __hip_atomic_store(&DG[unit * 128 + tid], __expf(cumtot), __ATOMIC_RELAXED, __HIP_MEMORY_SCOPE_AGENT);
    if (cnt) grp_arrive(cnt + 64 * bh);
}
__device__ __forceinline__ void hg_unit_c(LAS unsigned char* lds, int unit, const float* G, bf16_t* HQ, const bf16_t* HI, const float* ST, const float* ng) {
    const int tid = threadIdx.x, lane = tid & 63, w = tid >> 6, r = lane & 15, g = lane >> 4;
    const int bh = unit >> 5, c = unit & 31, b = bh >> 3, h = bh & 7;
    f32x4 S[8];
    {
        const float* U = ST + (size_t)unit * 16384;
#pragma unroll
        for (int i = 0; i < 8; ++i)
#pragma unroll
            for (int rg = 0; rg < 4; ++rg) S[i][rg] = U[(16 * i + 4 * g + rg) * 128 + 16 * w + r];
    }
    LAS bf16_t* qt = (LAS bf16_t*)(lds + HG_QT);
    LAS bf16_t* kt = (LAS bf16_t*)(lds + HG_KT);
    LAS bf16_t* vT = (LAS bf16_t*)(lds + HG_VT);
    LAS bf16_t* As = (LAS bf16_t*)(lds + HG_AS);
    LAS bf16_t* SpT = (LAS bf16_t*)(lds + HG_SP) + w * (16 * 136);
    LAS float* Os = (LAS float*)(lds + HG_QT);
    const LAS float* dm = (const LAS float*)(lds + HG_DM);
    HgRegs R;
    hg_load<true>(R, (size_t)b * SEQ + c * 256, h, G, HQ, HI);
    for (int sc = 0; sc < 4; ++sc) {
        const size_t m0 = (size_t)b * SEQ + c * 256 + sc * 64;
        __syncthreads();
        (void)hg_prep<true>(lds, R);
        if (sc < 3) hg_load<true>(R, m0 + 64, h, G, HQ, HI);
        __syncthreads();
#pragma unroll
        for (int i = 0; i < 8; ++i) {
            const f32x4 d = *(const LAS f32x4*)(dm + 16 * i + 4 * g);
            const f32x4 s = S[i] * d;
            *(LAS u32x2*)(SpT + r * 136 + 16 * i + 4 * g) = (u32x2){cvt_pk_bf16(s[0], s[1]), cvt_pk_bf16(s[2], s[3])};
        }
#pragma unroll
        for (int tt = 0; tt < 2; ++tt) {
            const int tile = 2 * w + tt, ti = tile >> 2, si = tile & 3;
            f32x4 a = (f32x4){0.f, 0.f, 0.f, 0.f};
            if (si <= ti) {
#pragma unroll
                for (int kk = 0; kk < 4; ++kk) {
                    const bf16x8 af = *(const LAS bf16x8*)(qt + (16 * ti + r) * 136 + 32 * kk + 8 * g);
                    const bf16x8 bf = *(const LAS bf16x8*)(kt + (16 * si + r) * 136 + 32 * kk + 8 * g);
                    a = __builtin_amdgcn_mfma_f32_16x16x32_bf16(af, bf, a, 0, 0, 0);
                }
            }
#pragma unroll
            for (int rg = 0; rg < 4; ++rg) {
                const int t = 16 * ti + 4 * g + rg, s = 16 * si + r;
                As[t * 72 + s] = (bf16_t)f2bf((s <= t) ? a[rg] : 0.f);
            }
        }
        __syncthreads();
        f32x4 o[4];
        {
            const bf16x8 vb0 = *(const LAS bf16x8*)(vT + (16 * w + r) * 72 + 8 * g), vb1 = *(const LAS bf16x8*)(vT + (16 * w + r) * 72 + 32 + 8 * g);
            bf16x8 sb[4];
#pragma unroll
            for (int kk = 0; kk < 4; ++kk) sb[kk] = *(const LAS bf16x8*)(SpT + r * 136 + 32 * kk + 8 * g);
#pragma unroll
            for (int ti = 0; ti < 4; ++ti) {
                f32x4 a = (f32x4){0.f, 0.f, 0.f, 0.f};
                const bf16x8 a0 = *(const LAS bf16x8*)(As + (16 * ti + r) * 72 + 8 * g), a1 = *(const LAS bf16x8*)(As + (16 * ti + r) * 72 + 32 + 8 * g);
                a = __builtin_amdgcn_mfma_f32_16x16x32_bf16(a0, vb0, a, 0, 0, 0);
                a = __builtin_amdgcn_mfma_f32_16x16x32_bf16(a1, vb1, a, 0, 0, 0);
#pragma unroll
                for (int kk = 0; kk < 4; ++kk) {
                    const bf16x8 qf = *(const LAS bf16x8*)(qt + (16 * ti + r) * 136 + 32 * kk + 8 * g);
                    a = __builtin_amdgcn_mfma_f32_16x16x32_bf16(qf, sb[kk], a, 0, 0, 0);
                }
                o[ti] = a;
            }
        }
        hg_state_update(lds, S, w, r, g);
        __syncthreads();
#pragma unroll
        for (int ti = 0; ti < 4; ++ti)
#pragma unroll
            for (int rg = 0; rg < 4; ++rg) Os[(16 * ti + 4 * g + rg) * 132 + 16 * w + r] = o[ti][rg];
        __syncthreads();
        {
            const int t = tid >> 3, sg = tid & 7;
            f32x4 v[4]; float ss = 0.f;
#pragma unroll
            for (int i = 0; i < 4; ++i) { v[i] = *(const LAS f32x4*)(Os + t * 132 + 16 * sg + 4 * i); ss += (v[i][0] * v[i][0] + v[i][1] * v[i][1]) + (v[i][2] * v[i][2] + v[i][3] * v[i][3]); }
            ss += __shfl_xor(ss, 1); ss += __shfl_xor(ss, 2); ss += __shfl_xor(ss, 4);
            const float rstd = __builtin_amdgcn_rsqf(ss * (1.f / 128.f) + RMS_EPS);
            const float* gp = ng + h * 128 + 16 * sg;
            unsigned pk[8];
#pragma unroll
            for (int i = 0; i < 4; ++i) {
                const f32x4 gg = *(const f32x4*)(gp + 4 * i);
                pk[2 * i] = cvt_pk_bf16(v[i][0] * rstd * gg[0], v[i][1] * rstd * gg[1]);
                pk[2 * i + 1] = cvt_pk_bf16(v[i][2] * rstd * gg[2], v[i][3] * rstd * gg[3]);
            }
            bf16_t* op = HQ + (m0 + t) * 1024 + h * 128 + 16 * sg;
            *(u32x4*)op = (u32x4){pk[0], pk[1], pk[2], pk[3]};
            *(u32x4*)(op + 8) = (u32x4){pk[4], pk[5], pk[6], pk[7]};
        }
    }
}

#define XB_TMO      128
#define XB_XCNT(j)  (256  + 64 * (j))
#define XB_XSUB(j)  (1280 + 64 * (j))
#define XB_XGEN(j)  (2304 + 64 * (j))
#define XB_TOP      3328
#define XB_TOPGEN   3392
#define XCD_BAR_WORDS 3456
#define XB_SPIN_CAP (1u << 18)
__device__ __forceinline__ unsigned xb_ld(unsigned* p)              { return __hip_atomic_load(p, __ATOMIC_RELAXED, __HIP_MEMORY_SCOPE_AGENT); }
__device__ __forceinline__ unsigned xb_add(unsigned* p, unsigned v) { return __hip_atomic_fetch_add(p, v, __ATOMIC_RELAXED, __HIP_MEMORY_SCOPE_AGENT); }
__device__ __forceinline__ unsigned xb_xcc_id() { return (unsigned)__builtin_amdgcn_s_getreg((3 << 11) | 20) & 0xFu; }
#define XB_SPIN(cond, bar) do { unsigned _sp = 0; while (cond) { __builtin_amdgcn_s_sleep(1); \
    if ((++_sp & 255u) == 0u) { if (xb_ld(&(bar)[XB_TMO])) break; if (_sp > XB_SPIN_CAP) { atomicAdd(&(bar)[XB_TMO], 1u); break; } } } } while (0)
struct XcdBarrier { unsigned* bar; unsigned x; volatile LAS unsigned* st; };
__device__ __forceinline__ XcdBarrier xcd_barrier_post(unsigned* bar, volatile LAS unsigned* st) {
    XcdBarrier b; b.bar = bar; b.x = xb_xcc_id(); b.st = st;
    if (threadIdx.x == 0) (void)xb_add(&bar[XB_XCNT(b.x)], 1u);
    return b;
}
__device__ __forceinline__ void xcd_barrier_complete(unsigned* bar, unsigned x, unsigned& nloc, unsigned& nx) {
    const unsigned G = gridDim.x * gridDim.y * gridDim.z;
    unsigned sum, cnt, mine, sp = 0u;
    for (;;) {
        sum = 0u; cnt = 0u; mine = 0u;
#pragma unroll
        for (unsigned j = 0; j < 16; ++j) { const unsigned c = xb_ld(&bar[XB_XCNT(j)]); sum += c; cnt += (c > 0u) ? 1u : 0u; mine = (j == x) ? c : mine; }
        if (sum == G) break;
        __builtin_amdgcn_s_sleep(1);
        if ((++sp & 255u) == 0u) { if (xb_ld(&bar[XB_TMO])) break; if (sp > XB_SPIN_CAP) { atomicAdd(&bar[XB_TMO], 1u); break; } }
    }
    nloc = mine > 0u ? mine : 1u; nx = cnt > 0u ? cnt : 1u;
}
__device__ __forceinline__ void xcd_barrier(const XcdBarrier& b) {
    asm volatile("s_waitcnt vmcnt(0)" ::: "memory");
    __syncthreads();
    if (threadIdx.x == 0) {
        unsigned* bar = b.bar;
        __builtin_amdgcn_s_waitcnt(0);
        unsigned nloc = b.st[0], nx = b.st[1];
        if (nloc == 0u) { xcd_barrier_complete(bar, b.x, nloc, nx); b.st[0] = nloc; b.st[1] = nx; }
        const unsigned old = xb_add(&bar[XB_XSUB(b.x)], 1u);
        const unsigned gen = old / nloc;
        if (old + 1u == (gen + 1u) * nloc) {
            __builtin_amdgcn_fence(__ATOMIC_RELEASE, "agent");
            asm volatile("s_waitcnt vmcnt(0)" ::: "memory");
            const unsigned og = xb_add(&bar[XB_TOP], 1u);
            const unsigned tg = og / nx;
            if (og + 1u == (tg + 1u) * nx) xb_add(&bar[XB_TOPGEN], 1u);
            else XB_SPIN(xb_ld(&bar[XB_TOPGEN]) == tg, bar);
            __builtin_amdgcn_fence(__ATOMIC_ACQUIRE, "agent");
            xb_add(&bar[XB_XGEN(b.x)], 1u);
            asm volatile("s_waitcnt vmcnt(0)" ::: "memory");
        } else {
            XB_SPIN(xb_ld(&bar[XB_XGEN(b.x)]) == gen, bar);
            __builtin_amdgcn_fence(__ATOMIC_ACQUIRE, "agent");
            asm volatile("s_waitcnt vmcnt(0)" ::: "memory");
        }
    }
    __syncthreads();
}

struct Args { const float* in[10]; float* out; unsigned char* ws; int ph_lo, ph_hi; };
__global__ void __launch_bounds__(512, 2) mk_fwd(Args args) {
    extern __shared__ __attribute__((aligned(16))) unsigned char lds_raw[];
    LAS unsigned char* lds = (LAS unsigned char*)lds_raw;
    cg::grid_group grid = cg::this_grid();
    const int tid = threadIdx.x, lane = tid & 63, wave = tid >> 6;
    const int G = gridDim.x, bid = blockIdx.x;
    unsigned char* ws = args.ws;
    const float* x = args.in[0]; const float* norm_g = args.in[1]; const float* w_in = args.in[2]; const float* b_gate = args.in[3];
    const float* lb_logits = args.in[4]; const float* hg_norm_g = args.in[5]; const float* w_sb = args.in[6]; const float* w_hg = args.in[7];
    const float* w_out = args.in[8]; const float* fng = args.in[9];
    float* out = args.out;
    bf16_t* Wt_in = (bf16_t*)(ws + WS_WIN); bf16_t* Wt_sbhg = (bf16_t*)(ws + WS_WSBHG); bf16_t* Wt_out = (bf16_t*)(ws + WS_WOUT);
    float* DG = (float*)(ws + WS_HGD);
    bf16_t* Hn = (bf16_t*)(ws + WS_H); bf16_t* SBQ = (bf16_t*)(ws + WS_SBQ); bf16_t* HGQ = (bf16_t*)(ws + WS_HGQ);
    bf16_t* SBK = (bf16_t*)(ws + WS_SBK); bf16_t* SBV = (bf16_t*)(ws + WS_SBV); bf16_t* HGI = (bf16_t*)(ws + WS_HGI);
    float* ST = (float*)(ws + WS_ST); bf16_t* GATES = (bf16_t*)(ws + WS_GATES); bf16_t* Y = (bf16_t*)(ws + WS_Y);
    float* Gf = out;
    const int lo = args.ph_lo, hi = args.ph_hi;
    if (lo < 0) grid.sync();
    if (tid < 16) ((LAS unsigned*)(lds + LDS_MISC))[tid] = 0u;
    __syncthreads();
    XcdBarrier bar = xcd_barrier_post((unsigned*)ws, (volatile LAS unsigned*)(lds + LDS_MISC));
#define IN(k) (lo <= (k) && (k) < hi)
#define SEAM(k) do { if (IN(k) && IN((k) + 1)) xcd_barrier(bar); } while (0)

    if (IN(0)) {
        LAS float* scr = (LAS float*)(lds + wave * 16384);
        const int gw = bid * 8 + wave, NGW = G * 8;
        for (int it = gw; it < 16 * 192; it += NGW) {
            const int kb = it / 192, j = it % 192, sg = j >> 5, seg = sg < 3 ? sg : sg + 1;
            p0_transpose_kn(w_in, 1024, 10240, Wt_in, 0, scr, kb, seg * 32 + (j & 31), lane);
        }
        for (int m4 = gw * 4; m4 < M_TOK; m4 += NGW * 4) {
            f32x4 v[4][4]; float s2[4];
#pragma unroll
            for (int q = 0; q < 4; ++q) { const f32x4* xr = (const f32x4*)(x + (size_t)(m4 + q) * 1024) + lane;
#pragma unroll
                for (int j = 0; j < 4; ++j) v[q][j] = xr[64 * j]; }
#pragma unroll
            for (int q = 0; q < 4; ++q) { s2[q] = 0.f;
#pragma unroll
                for (int j = 0; j < 4; ++j) s2[q] += (v[q][j][0] * v[q][j][0] + v[q][j][1] * v[q][j][1]) + (v[q][j][2] * v[q][j][2] + v[q][j][3] * v[q][j][3]); }
#pragma unroll
            for (int o = 1; o < 64; o <<= 1) {
#pragma unroll
                for (int q = 0; q < 4; ++q) s2[q] += __shfl_xor(s2[q], o); }
#pragma unroll
            for (int q = 0; q < 4; ++q) {
                const float rstd = __builtin_amdgcn_rsqf(s2[q] * (1.f / 1024.f) + RMS_EPS);
                u32x2* o8 = (u32x2*)(Hn + (size_t)(m4 + q) * 1024) + lane;
#pragma unroll
                for (int j = 0; j < 4; ++j) { const f32x4 gg = *((const f32x4*)norm_g + lane + 64 * j);
                    o8[64 * j] = (u32x2){pk2(v[q][j][0] * rstd * gg[0], v[q][j][1] * rstd * gg[1]), pk2(v[q][j][2] * rstd * gg[2], v[q][j][3] * rstd * gg[3])}; }
            }
        }
        __syncthreads();
    }
    SEAM(0);
    if (IN(1)) {
        pg8::Gemm g{Hn, Wt_in, M_TOK, 10240, 1024}; pg8::SegOrder S; S.init(G, bid, 0);
        EpiA E{SBQ, SBK, SBV, HGQ, HGI, Gf, lb_logits};
        pg8::gemm_phase<EpiA, pg8::SegOrder, true, true>(lds, g, S, E);
    }
    SEAM(1);
    const bool scan_in_p2 = (G == 256);
    unsigned* cntA = (unsigned*)(ws + 65536);
    unsigned* cntS = (unsigned*)(ws + 65536 + 4096);
    if (IN(2)) {
        for (int u = bid; u < 512; u += G) hg_unit_a(lds, u, Gf, HGI, ST, DG, scan_in_p2 ? cntA : nullptr);
        __syncthreads();
        for (int u = bid; u < 1024; u += G) sb_unit(lds, u, SBQ, SBK, SBV);
        __syncthreads();
        if (scan_in_p2) {
            grp_wait(cntA + 64 * (bid >> 5), 32u); grp_wait(cntA + 64 * ((bid >> 5) + 8), 32u);
#pragma unroll
            for (int j = 0; j < 2; ++j) {
                const int bh = (bid >> 5) + 8 * j;
                const int kv = (bid & 31) * 512 + tid, k = kv >> 7;
                float* stp = ST + ((size_t)(bh * 32) << 14) + kv;
                const float* dgp = DG + (bh * 32) * 128 + k;
                float u[32], d[32];
#pragma unroll
                for (int c = 0; c < 32; ++c) { u[c] = stp[(size_t)c << 14]; d[c] = dgp[c * 128]; }
                float S = 0.f;
#pragma unroll
                for (int c = 0; c < 32; ++c) { __hip_atomic_store(&stp[(size_t)c << 14], S, __ATOMIC_RELAXED, __HIP_MEMORY_SCOPE_AGENT); S = d[c] * S + u[c]; }
            }
            grp_arrive(cntS + 64 * (bid >> 5));
        }
    }
    if (!scan_in_p2) SEAM(2);
    if (IN(3) && !scan_in_p2) {
        for (int e = bid * 512 + tid; e < 16 * 16384; e += G * 512) {
            const int bh = e >> 14, kv = e & 16383, k = kv >> 7;
            float* stp = ST + ((size_t)(bh * 32) << 14) + kv;
            const float* dgp = DG + (bh * 32) * 128 + k;
            float u[32], d[32];
#pragma unroll
            for (int c = 0; c < 32; ++c) { u[c] = stp[(size_t)c << 14]; d[c] = dgp[c * 128]; }
            float S = 0.f;
#pragma unroll
            for (int c = 0; c < 32; ++c) { stp[(size_t)c << 14] = S; S = d[c] * S + u[c]; }
        }
    }
    if (IN(3) && IN(4) && !scan_in_p2) xcd_barrier(bar);
    if (IN(4)) {
        if (scan_in_p2) grp_wait(cntS + 64 * (bid >> 5), 32u);
        {
            LAS float* scr = (LAS float*)(lds + wave * 16384);
            const int gw = bid * 8 + wave, NGW = G * 8;
            for (int it = gw; it < 16 * 128 + 3 * 512; it += NGW) {
                int r = it;
                if (r < 16 * 128) { const int kb = r / 128, j = r % 128, sg = j >> 5, seg = sg == 0 ? 3 : sg + 6; p0_transpose_kn(w_in, 1024, 10240, Wt_in, 0, scr, kb, seg * 32 + (j & 31), lane); continue; } r -= 16 * 128;
                if (r < 512) { p0_transpose_kn(w_sb, 1024, 1024, Wt_sbhg, 0, scr, r / 32, r % 32, lane); continue; } r -= 512;
                if (r < 512) { p0_transpose_kn(w_hg, 1024, 1024, Wt_sbhg, 1024, scr, r / 32, r % 32, lane); continue; } r -= 512;
                p0_transpose_kn(w_out, 1024, 1024, Wt_out, 0, scr, r / 32, r % 32, lane);
            }
            __syncthreads();
        }
        for (int u = bid; u < 512; u += G) hg_unit_c(lds, u, Gf, HGQ, HGI, ST, hg_norm_g);
        __syncthreads();
    }
    SEAM(4);
    if (IN(5)) {
        pg8::Gemm g{Hn, Wt_in, M_TOK, 10240, 1024}; pg8::SegOrder S; S.init(G, bid, 1);
        EpiB E{SBQ, HGQ, GATES, b_gate};
        pg8::gemm_phase<EpiB, pg8::SegOrder, true, true>(lds, g, S, E);
    }
    SEAM(5);
    if (IN(6)) {
        pg8::Gemm g{SBQ, Wt_sbhg, 2 * M_TOK, 2048, 1024}; pg8::PairOrder S; S.init(G, bid);
        EpiC E{GATES, out, Y};
        pg8::gemm_phase<EpiC, pg8::PairOrder, true, true>(lds, g, S, E);
    }
    SEAM(6);
    if (IN(7)) {
        pg8::Gemm g{Y, Wt_out, M_TOK, 1024, 1024}; pg8::PlainOrder S; S.init(M_TOK, 1024, G, bid);
        EpiD E{x, out, fng, (float*)(ws + 131072), (unsigned*)(ws + 16384)};
        pg8::gemm_phase<EpiD, pg8::PlainOrder, true, true>(lds, g, S, E);
    }
#undef IN
#undef SEAM
}

#ifndef MK_N_LAUNCHES
#define MK_N_LAUNCHES 1
#endif
extern "C" void kernel_launch(void* const* d_in, const int* in_sizes, int n_in, void* d_out, int out_size, void* d_ws, size_t ws_size, hipStream_t stream) {
    static int grid = 0;
    if (grid == 0) {
        if (n_in != 10 || out_size != M_TOK * DM || ws_size < WS_END) { fprintf(stderr, "kernel_launch: unexpected shapes (n_in %d out %d ws %zu)\n", n_in, out_size, ws_size); grid = -1; return; }
        int dev = 0, cus = 0, per_cu = 0;
        (void)hipGetDevice(&dev);
        (void)hipDeviceGetAttribute(&cus, hipDeviceAttributeMultiprocessorCount, dev);
        if (hipFuncSetAttribute((const void*)mk_fwd, hipFuncAttributeMaxDynamicSharedMemorySize, LDS_BYTES) != hipSuccess) { fprintf(stderr, "kernel_launch: hipFuncSetAttribute failed\n"); grid = -1; return; }
        if (hipOccupancyMaxActiveBlocksPerMultiprocessor(&per_cu, (const void*)mk_fwd, 512, LDS_BYTES) != hipSuccess || per_cu < 1) { fprintf(stderr, "kernel_launch: occupancy query says %d\n", per_cu); per_cu = 1; }
        (void)hipGetLastError();
        grid = cus > 0 ? cus : 256;
    }
    if (grid < 0) return;
    if (hipMemsetAsync(d_ws, 0, 65536 + 8192, stream) != hipSuccess) { fprintf(stderr, "kernel_launch: memset failed\n"); return; }
    Args a{};
    for (int i = 0; i < 10; ++i) a.in[i] = (const float*)d_in[i];
    a.out = (float*)d_out; a.ws = (unsigned char*)d_ws;
#if MK_N_LAUNCHES == 1
    a.ph_lo = 0; a.ph_hi = 8;
    void* kargs[] = {&a};
    hipError_t e = hipLaunchCooperativeKernel((const void*)mk_fwd, dim3(grid), dim3(512), kargs, LDS_BYTES, stream);
    if (e != hipSuccess) fprintf(stderr, "kernel_launch: cooperative launch failed: %s (grid %d)\n", hipGetErrorString(e), grid);
#else
    for (int p = 0; p < 8; ++p) { a.ph_lo = p; a.ph_hi = p + 1; hipLaunchKernelGGL(mk_fwd, dim3(grid), dim3(512), LDS_BYTES, stream, a); }
#endif
}
```

```cpp
#include <hip/hip_runtime.h>
#include <hip/hip_cooperative_groups.h>
#include <cstdio>
#include <cstdint>
namespace cg = cooperative_groups;

#define LAS __attribute__((address_space(3)))
typedef unsigned short bf16_t;
typedef short bf16x8 __attribute__((ext_vector_type(8)));
typedef float f32x4 __attribute__((ext_vector_type(4)));
typedef unsigned u32x4 __attribute__((ext_vector_type(4)));
typedef unsigned u32x2 __attribute__((ext_vector_type(2)));

namespace pg8 {
constexpr int BM = 256, BK = 64, HALF = 128, HTB = HALF * BK * 2, STAGE_BYTES = 8 * HTB, NXCD = 8, WGM = 8;
__host__ __device__ __forceinline__ int lds_byte(int r, int c) { const int st = (r >> 4) * 2 + (c >> 5), rr = r & 15, cc = c & 31, ob = rr * 64 + cc * 2; return st * 1024 + (ob ^ (((ob >> 9) & 1) << 5)); }
__host__ __device__ __forceinline__ void stage_rc(int b, int& R, int& C) { const int st = b / 1024, sb = b % 1024, swz = sb ^ (((sb >> 9) & 1) << 5); R = (st >> 1) * 16 + swz / 64; C = (st & 1) * 32 + (swz % 64) / 2; }
__host__ __device__ __forceinline__ int perm32(int rho) { const int n = rho >> 4, i = rho & 15; return 8 * (i >> 2) + 4 * n + (i & 3); }

struct Unit { int pm, pn; };
struct Gemm { const bf16_t* A; const bf16_t* Bt; int M, N, K; };

struct StaticOrder {
    int nM, nN, nwg, G, c;
    __host__ __device__ void init(int M, int N, int G_, int c_) { nM = M / BM; nN = N / BM; nwg = nM * nN; G = G_; c = c_; }
    __host__ __device__ bool next(int i, Unit& u) const {
        const long L = (long)i * G + c; if (L >= nwg) return false;
        int wgid = (int)L; { const int q = nwg / NXCD, r = nwg % NXCD, xcd = wgid % NXCD, off = wgid / NXCD; wgid = (xcd < r ? xcd * (q + 1) : r * (q + 1) + (xcd - r) * q) + off; }
        const int nig = WGM * nN, gid = wgid / nig, fm = gid * WGM, gsz = (nM - fm) < WGM ? (nM - fm) : WGM;
        u.pm = fm + ((wgid % nig) % gsz); u.pn = (wgid % nig) / gsz; return true;
    }
};
struct SegOrder {
    StaticOrder so; int mode;
    __device__ void init(int G, int c, int mode_) { mode = mode_; so.init(16384, (mode_ == 0 ? 24 : 16) * 256, G, c); }
    __device__ bool next(int i, Unit& u) const {
        if (!so.next(i, u)) return false;
        if (mode == 0) u.pn = (u.pn < 12) ? u.pn : u.pn + 4; else u.pn = (u.pn < 4) ? u.pn + 12 : u.pn + 24;
        return true;
    }
    __device__ __forceinline__ void a_ready(const Unit&) const {}
    __device__ __forceinline__ void done(const Unit&) const {}
};
struct PairOrder {
    StaticOrder so;
    __device__ void init(int G, int c) { so.init(16384, 1024, G, c); }
    __device__ bool next(int i, Unit& u) const { if (!so.next(i >> 1, u)) return false; u.pm += 64 * (i & 1); u.pn += 4 * (i & 1); return true; }
    __device__ __forceinline__ void a_ready(const Unit&) const {}
    __device__ __forceinline__ void done(const Unit&) const {}
};
struct PlainOrder {
    StaticOrder so;
    __device__ void init(int M, int N, int G, int c) { so.init(M, N, G, c); }
    __device__ bool next(int i, Unit& u) const { return so.next(i, u); }
    __device__ __forceinline__ void a_ready(const Unit&) const {}
    __device__ __forceinline__ void done(const Unit&) const {}
};

typedef float f32x2_t __attribute__((ext_vector_type(2)));
typedef __bf16 bf16x2_t __attribute__((ext_vector_type(2)));
__device__ __forceinline__ unsigned cvt_pk_bf16(float lo, float hi) { f32x2_t v = {lo, hi}; bf16x2_t b = __builtin_convertvector(v, bf16x2_t); return __builtin_bit_cast(unsigned, b); }

template <class Epi, class Sched, bool ALIGN_EPI = false, bool SP2 = false>
__device__ __forceinline__ void gemm_phase(LAS unsigned char* lds, const Gemm g, const Sched& S, const Epi& E) {
    const int tid = threadIdx.x, wid = __builtin_amdgcn_readfirstlane(tid >> 6), lane = tid & 63, wr = wid >> 2, wc = wid & 3, fr = lane & 15, fq = lane >> 4;
    const int K = g.K, nt = K / BK;
    unsigned voffA[2], voffB[2];
#pragma unroll
    for (int i = 0; i < 2; ++i) { int R, C; stage_rc(tid * 16 + i * 8192, R, C); const int Rb = Epi::PERM ? ((R & ~31) + perm32(R & 31)) : R;
        voffA[i] = (unsigned)(R * K + C) * 2u; voffB[i] = (unsigned)(Rb * K + C) * 2u; }
    const size_t kstep = (size_t)(BK * 2);
    const size_t hstep = (size_t)HALF * K * 2;
    const size_t tstep = 2 * hstep;
    const unsigned ldsw = (unsigned)wid * 1024u;
    const int aoff = lds_byte(wr * 64 + fr, fq * 8), boff = lds_byte(wc * 32 + fr, fq * 8);
#define PG8_SA(b, h) (((b) * 2 + (h)) * HTB)
#define PG8_SB(b, h) ((4 + (b) * 2 + (h)) * HTB)
#define PG8_STAGE(bufoff, gbase, voff) do { _Pragma("unroll") for (int _i = 0; _i < 2; ++_i) \
        __builtin_amdgcn_global_load_lds((const unsigned*)((const char*)(gbase) + (voff)[_i]), (LAS unsigned*)(lds + (bufoff) + ldsw + _i * 8192), 16, 0, 0); } while (0)
#define PG8_LDA(dst, b, h) do { _Pragma("unroll") for (int m = 0; m < 4; ++m) _Pragma("unroll") for (int k = 0; k < 2; ++k) dst[m][k] = *(const LAS bf16x8*)(lds + PG8_SA(b, h) + aoff + m * 2048 + k * 1024); } while (0)
#define PG8_LDB(dst, b, h) do { _Pragma("unroll") for (int n = 0; n < 2; ++n) _Pragma("unroll") for (int k = 0; k < 2; ++k) dst[n][k] = *(const LAS bf16x8*)(lds + PG8_SB(b, h) + boff + n * 2048 + k * 1024); } while (0)
#define PG8_MMA(ai, bj, At, Bt) do { __builtin_amdgcn_s_setprio(1); _Pragma("unroll") for (int m = 0; m < 4; ++m) _Pragma("unroll") for (int n = 0; n < 2; ++n) _Pragma("unroll") for (int k = 0; k < 2; ++k) \
        acc[ai][bj][m][n] = __builtin_amdgcn_mfma_f32_16x16x32_bf16(Bt[n][k], At[m][k], acc[ai][bj][m][n], 0, 0, 0); __builtin_amdgcn_s_setprio(0); } while (0)
#define PG8_WAIT_V(n) asm volatile("s_waitcnt vmcnt(" #n ")" ::: "memory")
#define PG8_WAIT_L(n) asm volatile("s_waitcnt lgkmcnt(" #n ")" ::: "memory")
#define PG8_BAR __builtin_amdgcn_s_barrier()
#define PG8_SCHED __builtin_amdgcn_sched_barrier(0)
    Unit cur, nxt; int ui = 0;
    if (!S.next(0, cur)) return;
    f32x4 acc[2][2][4][2];
#pragma unroll
    for (int a = 0; a < 2; ++a)
#pragma unroll
        for (int b = 0; b < 2; ++b)
#pragma unroll
            for (int m = 0; m < 4; ++m)
#pragma unroll
                for (int n = 0; n < 2; ++n) acc[a][b][m][n] = (f32x4){0.f, 0.f, 0.f, 0.f};
    bf16x8 At[4][2], B0[2][2], B1[2][2];
    const char* cA = (const char*)g.A + (size_t)cur.pm * tstep; const char* cB = (const char*)g.Bt + (size_t)cur.pn * tstep;
    S.a_ready(cur);
    if constexpr (SP2) {
        PG8_STAGE(PG8_SB(0, 0), cB, voffB); PG8_STAGE(PG8_SB(0, 1), cB + hstep, voffB); PG8_STAGE(PG8_SA(0, 0), cA, voffA); PG8_STAGE(PG8_SA(0, 1), cA + hstep, voffA);
        if (wr == 1) PG8_BAR;
        PG8_WAIT_V(2); PG8_BAR;
        PG8_STAGE(PG8_SB(1, 0), cB + kstep, voffB); PG8_STAGE(PG8_SA(1, 0), cA + kstep, voffA); PG8_STAGE(PG8_SB(1, 1), cB + hstep + kstep, voffB);
        PG8_WAIT_V(6); PG8_BAR;
    } else {
        PG8_STAGE(PG8_SB(0, 0), cB, voffB); PG8_STAGE(PG8_SA(0, 0), cA, voffA); PG8_STAGE(PG8_SB(0, 1), cB + hstep, voffB); PG8_STAGE(PG8_SA(0, 1), cA + hstep, voffA);
        if (wr == 1) PG8_BAR;
        PG8_WAIT_V(4); PG8_BAR;
        PG8_STAGE(PG8_SB(1, 0), cB + kstep, voffB); PG8_STAGE(PG8_SA(1, 0), cA + kstep, voffA); PG8_STAGE(PG8_SB(1, 1), cB + hstep + kstep, voffB);
        PG8_WAIT_V(6); PG8_BAR;
    }
    for (;;) {
        const bool has_next = S.next(ui + 1, nxt);
        const char* nA = has_next ? (const char*)g.A + (size_t)nxt.pm * tstep : cA; const char* nB = has_next ? (const char*)g.Bt + (size_t)nxt.pn * tstep : cB;
        for (int t = 0; t < nt; t += 2) {
            const bool last = (t == nt - 2);
            const char* a1 = cA + (size_t)(t + 1) * kstep;
            const char* a2 = last ? nA : cA + (size_t)(t + 2) * kstep; const char* b2 = last ? nB : cB + (size_t)(t + 2) * kstep;
            const char* a3 = a2 + kstep; const char* b3 = b2 + kstep;
            if (last && has_next) S.a_ready(nxt);
            if constexpr (SP2) {
            PG8_LDB(B0, 0, 0); PG8_LDB(B1, 0, 1); PG8_SCHED; PG8_LDA(At, 0, 0); PG8_STAGE(PG8_SA(1, 1), a1 + hstep, voffA);
            PG8_WAIT_V(8); PG8_WAIT_L(0); PG8_BAR; PG8_MMA(0, 0, At, B0); PG8_MMA(0, 1, At, B1); PG8_BAR; PG8_SCHED;
            PG8_LDA(At, 0, 1); PG8_STAGE(PG8_SB(0, 0), b2, voffB); PG8_STAGE(PG8_SB(0, 1), b2 + hstep, voffB); PG8_STAGE(PG8_SA(0, 0), a2, voffA);
            PG8_WAIT_V(8); PG8_WAIT_L(0); PG8_BAR; PG8_MMA(1, 0, At, B0); PG8_MMA(1, 1, At, B1); PG8_BAR; PG8_SCHED;
            PG8_LDB(B0, 1, 0); PG8_LDB(B1, 1, 1); PG8_SCHED; PG8_LDA(At, 1, 0); PG8_STAGE(PG8_SA(0, 1), a2 + hstep, voffA);
            PG8_WAIT_V(8); PG8_WAIT_L(0); PG8_BAR; PG8_MMA(0, 0, At, B0); PG8_MMA(0, 1, At, B1); PG8_BAR; PG8_SCHED;
            PG8_LDA(At, 1, 1); PG8_STAGE(PG8_SB(1, 0), b3, voffB); PG8_STAGE(PG8_SB(1, 1), b3 + hstep, voffB); PG8_STAGE(PG8_SA(1, 0), a3, voffA);
            PG8_WAIT_V(8); PG8_WAIT_L(0); PG8_BAR; PG8_MMA(1, 0, At, B0); PG8_MMA(1, 1, At, B1); PG8_BAR; PG8_SCHED;
            } else {
            PG8_LDB(B0, 0, 0); PG8_SCHED; PG8_LDA(At, 0, 0); PG8_STAGE(PG8_SA(1, 1), a1 + hstep, voffA);
            PG8_WAIT_L(8); PG8_BAR; PG8_WAIT_L(0); PG8_MMA(0, 0, At, B0); PG8_BAR; PG8_SCHED;
            PG8_LDB(B1, 0, 1); PG8_STAGE(PG8_SB(0, 0), b2, voffB);
            PG8_BAR; PG8_WAIT_L(0); PG8_MMA(0, 1, At, B1); PG8_BAR;
            PG8_LDA(At, 0, 1); PG8_STAGE(PG8_SA(0, 0), a2, voffA);
            PG8_BAR; PG8_WAIT_L(0); PG8_MMA(1, 0, At, B0); PG8_BAR; PG8_SCHED;
            PG8_STAGE(PG8_SB(0, 1), b2 + hstep, voffB);
            PG8_WAIT_V(6); PG8_BAR; PG8_MMA(1, 1, At, B1); PG8_BAR;
            PG8_LDB(B0, 1, 0); PG8_SCHED; PG8_LDA(At, 1, 0); PG8_STAGE(PG8_SA(0, 1), a2 + hstep, voffA);
            PG8_WAIT_L(8); PG8_BAR; PG8_WAIT_L(0); PG8_MMA(0, 0, At, B0); PG8_BAR; PG8_SCHED;
            PG8_LDB(B1, 1, 1); PG8_STAGE(PG8_SB(1, 0), b3, voffB);
            PG8_BAR; PG8_WAIT_L(0); PG8_MMA(0, 1, At, B1); PG8_BAR;
            PG8_LDA(At, 1, 1); PG8_STAGE(PG8_SA(1, 0), a3, voffA);
            PG8_BAR; PG8_WAIT_L(0); PG8_MMA(1, 0, At, B0); PG8_BAR; PG8_SCHED;
            PG8_STAGE(PG8_SB(1, 1), b3 + hstep, voffB);
            PG8_WAIT_V(6); PG8_BAR; PG8_MMA(1, 1, At, B1); PG8_BAR;
            }
        }
        if constexpr (ALIGN_EPI) { if (wr == 0) PG8_BAR; }
        if constexpr (!Epi::AFTER_DRAIN) { E(acc, cur, wr, wc, fr, fq); S.done(cur); }
        if (!has_next) break;
#pragma unroll
        for (int a = 0; a < 2; ++a)
#pragma unroll
            for (int b = 0; b < 2; ++b)
#pragma unroll
                for (int m = 0; m < 4; ++m)
#pragma unroll
                    for (int n = 0; n < 2; ++n) acc[a][b][m][n] = (f32x4){0.f, 0.f, 0.f, 0.f};
        cur = nxt; cA = nA; cB = nB; ++ui;
        if constexpr (ALIGN_EPI) { if (wr == 1) PG8_BAR; }
    }
    PG8_WAIT_V(0);
    if constexpr (!ALIGN_EPI) { if (wr == 0) PG8_BAR; }
    PG8_BAR;
    if constexpr (Epi::AFTER_DRAIN) { E.fused(acc, cur, wr, wc, fr, fq, lds, wid, lane); S.done(cur); }
#undef PG8_SA
#undef PG8_SB
#undef PG8_STAGE
#undef PG8_LDA
#undef PG8_LDB
#undef PG8_MMA
#undef PG8_WAIT_V
#undef PG8_WAIT_L
#undef PG8_BAR
#undef PG8_SCHED
}
}
using pg8::cvt_pk_bf16;

constexpr int M_TOK = 16384, DM = 1024, SEQ = 8192;
constexpr size_t MiB = 1u << 20;
constexpr size_t WS_ROWSQ = 128 * 1024;
constexpr size_t WS_WIN = 1 * MiB;
constexpr size_t WS_WSBHG = 21 * MiB;
constexpr size_t WS_WOUT = 25 * MiB;
constexpr size_t WS_HGD = 27 * MiB;
constexpr size_t WS_H = 28 * MiB;
constexpr size_t WS_SBQ = 60 * MiB;
constexpr size_t WS_HGQ = 92 * MiB;
constexpr size_t WS_SBK = 124 * MiB;
constexpr size_t WS_SBV = 156 * MiB;
constexpr size_t WS_HGI = 188 * MiB;
constexpr size_t WS_ST = 220 * MiB;
constexpr size_t WS_GATES = 124 * MiB;
constexpr size_t WS_Y = 188 * MiB;
constexpr size_t WS_END = 252 * MiB;
constexpr int LDS_BYTES = 163840, LDS_MISC = 163840 - 64;
constexpr float RMS_EPS = 1e-6f;

__device__ __forceinline__ float bf2f(unsigned u) { return __uint_as_float(u << 16); }
__device__ __forceinline__ unsigned f2bf(float f) { unsigned u = __float_as_uint(f); return (u + 0x7fffu + ((u >> 16) & 1u)) >> 16; }
__device__ __forceinline__ unsigned pk2(float lo, float hi) { return f2bf(lo) | (f2bf(hi) << 16); }
__device__ __forceinline__ float sigmoidf_(float v) { return __builtin_amdgcn_rcpf(1.f + __expf(-v)); }
__device__ __forceinline__ float siluf_(float v) { return v * sigmoidf_(v); }
__device__ __forceinline__ float wave_sum(float v) {
#pragma unroll
    for (int o = 1; o < 64; o <<= 1) v += __shfl_xor(v, o);
    return v;
}

struct EpiA {
    static constexpr bool AFTER_DRAIN = false;
    static constexpr bool PERM = true;
    bf16_t* sbq; bf16_t* sbk; bf16_t* sbv; bf16_t* hgq; bf16_t* hgi; float* G; const float* lbl;
    __device__ __forceinline__ void operator()(const f32x4 (&acc)[2][2][4][2], const pg8::Unit& u, int wr, int wc, int fr, int fq) const {
        const int seg = u.pn >> 2;
        const int row0 = u.pm * 256 + wr * 64 + fr, col0 = (u.pn & 3) * 256 + wc * 32 + 8 * fq;
        if (seg == 5) {
#pragma unroll
            for (int bj = 0; bj < 2; ++bj) {
                const int col = col0 + bj * 128;
                float lb[8];
#pragma unroll
                for (int j = 0; j < 8; ++j) lb[j] = __builtin_amdgcn_rcpf(1.f + __expf(lbl[1024 + col + j] - lbl[col + j]));
#pragma unroll
                for (int ai = 0; ai < 2; ++ai)
#pragma unroll
                    for (int m = 0; m < 4; ++m) {
                        bf16_t* p = (bf16_t*)G + (size_t)(row0 + ai * 128 + m * 16) * 1024 + col;
                        f32x4 a = acc[ai][bj][m][0], b = acc[ai][bj][m][1], ga, gb;
#pragma unroll
                        for (int j = 0; j < 4; ++j) { ga[j] = __logf(lb[j] + (1.f - lb[j]) * sigmoidf_(a[j])); gb[j] = __logf(lb[4 + j] + (1.f - lb[4 + j]) * sigmoidf_(b[j])); }
                        u32x4 w; w.x = cvt_pk_bf16(ga[0], ga[1]); w.y = cvt_pk_bf16(ga[2], ga[3]); w.z = cvt_pk_bf16(gb[0], gb[1]); w.w = cvt_pk_bf16(gb[2], gb[3]);
                        *(u32x4*)p = w;
                    }
            }
        } else {
            if (seg == 2) {
#pragma unroll
                for (int ai = 0; ai < 2; ++ai)
#pragma unroll
                    for (int m = 0; m < 4; ++m) {
                        const int row = row0 + ai * 128 + m * 16, bb = row >> 13, ss = row & 8191;
#pragma unroll
                        for (int bj = 0; bj < 2; ++bj) {
                            const int col = col0 + bj * 128;
                            bf16_t* p = sbv + ((size_t)(bb * 1024 + col)) * 8192 + ss;
                            const f32x4 a = acc[ai][bj][m][0], b = acc[ai][bj][m][1];
#pragma unroll
                            for (int j = 0; j < 4; ++j) { p[(size_t)j * 8192] = (bf16_t)f2bf(a[j]); p[(size_t)(4 + j) * 8192] = (bf16_t)f2bf(b[j]); }
                        }
                    }
                return;
            }
            bf16_t* base = seg == 0 ? sbq : seg == 1 ? sbk : seg == 2 ? sbv : seg == 4 ? hgq : hgi;
            const float sc = seg == 0 ? 0.08838834764831845f : 1.f; const bool act = seg == 4;
#pragma unroll
            for (int ai = 0; ai < 2; ++ai)
#pragma unroll
                for (int m = 0; m < 4; ++m)
#pragma unroll
                    for (int bj = 0; bj < 2; ++bj) {
                        f32x4 a = acc[ai][bj][m][0], b = acc[ai][bj][m][1];
                        if (act) {
#pragma unroll
                            for (int j = 0; j < 4; ++j) { a[j] = siluf_(a[j]); b[j] = siluf_(b[j]); } }
                        a = a * sc; b = b * sc;
                        u32x4 w; w.x = cvt_pk_bf16(a[0], a[1]); w.y = cvt_pk_bf16(a[2], a[3]); w.z = cvt_pk_bf16(b[0], b[1]); w.w = cvt_pk_bf16(b[2], b[3]);
                        *(u32x4*)(base + (size_t)(row0 + ai * 128 + m * 16) * 1024 + col0 + bj * 128) = w;
                    }
        }
    }
};
struct EpiB {
    static constexpr bool AFTER_DRAIN = false;
    static constexpr bool PERM = true;
    bf16_t* asb; bf16_t* ahg; bf16_t* gates; const float* bgate;
    __device__ __forceinline__ void operator()(const f32x4 (&acc)[2][2][4][2], const pg8::Unit& u, int wr, int wc, int fr, int fq) const {
        const int seg = u.pn >> 2;
        const int row0 = u.pm * 256 + wr * 64 + fr, col0 = (u.pn & 3) * 256 + wc * 32 + 8 * fq;
        if (seg >= 8) {
#pragma unroll
            for (int bj = 0; bj < 2; ++bj) {
                const int col = (seg - 8) * 1024 + col0 + bj * 128;
                const f32x4 b0 = *(const f32x4*)(bgate + col), b1 = *(const f32x4*)(bgate + col + 4);
#pragma unroll
                for (int ai = 0; ai < 2; ++ai)
#pragma unroll
                    for (int m = 0; m < 4; ++m) {
                        f32x4 a = acc[ai][bj][m][0] + b0, b = acc[ai][bj][m][1] + b1;
#pragma unroll
                        for (int j = 0; j < 4; ++j) { a[j] = sigmoidf_(a[j]); b[j] = sigmoidf_(b[j]); }
                        u32x4 w; w.x = cvt_pk_bf16(a[0], a[1]); w.y = cvt_pk_bf16(a[2], a[3]); w.z = cvt_pk_bf16(b[0], b[1]); w.w = cvt_pk_bf16(b[2], b[3]);
                        *(u32x4*)(gates + (size_t)(row0 + ai * 128 + m * 16) * 2048 + col) = w;
                    }
            }
        } else {
            bf16_t* base = seg == 3 ? asb : ahg;
#pragma unroll
            for (int ai = 0; ai < 2; ++ai) {
                u32x4 ov[4][2];
#pragma unroll
                for (int m = 0; m < 4; ++m)
#pragma unroll
                    for (int bj = 0; bj < 2; ++bj) ov[m][bj] = *(const u32x4*)(base + (size_t)(row0 + ai * 128 + m * 16) * 1024 + col0 + bj * 128);
#pragma unroll
                for (int m = 0; m < 4; ++m)
#pragma unroll
                    for (int bj = 0; bj < 2; ++bj) {
                        const u32x4 o = ov[m][bj];
                        const f32x4 a = acc[ai][bj][m][0], b = acc[ai][bj][m][1];
                        u32x4 w;
                        w.x = cvt_pk_bf16(bf2f(o.x & 0xffffu) * siluf_(a[0]), bf2f(o.x >> 16) * siluf_(a[1]));
                        w.y = cvt_pk_bf16(bf2f(o.y & 0xffffu) * siluf_(a[2]), bf2f(o.y >> 16) * siluf_(a[3]));
                        w.z = cvt_pk_bf16(bf2f(o.z & 0xffffu) * siluf_(b[0]), bf2f(o.z >> 16) * siluf_(b[1]));
                        w.w = cvt_pk_bf16(bf2f(o.w & 0xffffu) * siluf_(b[2]), bf2f(o.w >> 16) * siluf_(b[3]));
                        *(u32x4*)(base + (size_t)(row0 + ai * 128 + m * 16) * 1024 + col0 + bj * 128) = w;
                    }
            }
        }
    }
};
struct EpiC {
    static constexpr bool AFTER_DRAIN = false;
    static constexpr bool PERM = true;
    const bf16_t* gates; float* tmp; bf16_t* Y;
    __device__ __forceinline__ void operator()(const f32x4 (&acc)[2][2][4][2], const pg8::Unit& u, int wr, int wc, int fr, int fq) const {
        const bool second = u.pm >= 64;
        const int pm = second ? u.pm - 64 : u.pm, pn = second ? u.pn - 4 : u.pn;
        const int row0 = pm * 256 + wr * 64 + fr, col0 = pn * 256 + wc * 32 + 8 * fq;
#pragma unroll
        for (int ai = 0; ai < 2; ++ai)
#pragma unroll
        for (int mh = 0; mh < 2; ++mh) {
            u32x4 gv[2][2], tv[2][2];
#pragma unroll
            for (int mm = 0; mm < 2; ++mm)
#pragma unroll
                for (int bj = 0; bj < 2; ++bj) {
                    const size_t row = (size_t)(row0 + ai * 128 + (2 * mh + mm) * 16); const int col = col0 + bj * 128;
                    gv[mm][bj] = *(const u32x4*)(gates + row * 2048 + (second ? 1024 : 0) + col);
                    if (second) tv[mm][bj] = *(const u32x4*)((const bf16_t*)tmp + row * 1024 + col);
                }
#pragma unroll
            for (int mm = 0; mm < 2; ++mm)
#pragma unroll
                for (int bj = 0; bj < 2; ++bj) {
                    const int m = 2 * mh + mm;
                    const size_t row = (size_t)(row0 + ai * 128 + m * 16); const int col = col0 + bj * 128;
                    const u32x4 gt = gv[mm][bj];
                    f32x4 a = acc[ai][bj][m][0], b = acc[ai][bj][m][1];
                    a[0] *= bf2f(gt.x & 0xffffu); a[1] *= bf2f(gt.x >> 16); a[2] *= bf2f(gt.y & 0xffffu); a[3] *= bf2f(gt.y >> 16);
                    b[0] *= bf2f(gt.z & 0xffffu); b[1] *= bf2f(gt.z >> 16); b[2] *= bf2f(gt.w & 0xffffu); b[3] *= bf2f(gt.w >> 16);
                    if (!second) { u32x4 w; w.x = cvt_pk_bf16(a[0], a[1]); w.y = cvt_pk_bf16(a[2], a[3]); w.z = cvt_pk_bf16(b[0], b[1]); w.w = cvt_pk_bf16(b[2], b[3]); *(u32x4*)((bf16_t*)tmp + row * 1024 + col) = w; }
                    else {
                        { const u32x4 t = tv[mm][bj]; a[0] += bf2f(t.x & 0xffffu); a[1] += bf2f(t.x >> 16); a[2] += bf2f(t.y & 0xffffu); a[3] += bf2f(t.y >> 16);
                          b[0] += bf2f(t.z & 0xffffu); b[1] += bf2f(t.z >> 16); b[2] += bf2f(t.w & 0xffffu); b[3] += bf2f(t.w >> 16); }
                        u32x4 w; w.x = cvt_pk_bf16(a[0], a[1]); w.y = cvt_pk_bf16(a[2], a[3]); w.z = cvt_pk_bf16(b[0], b[1]); w.w = cvt_pk_bf16(b[2], b[3]);
                        *(u32x4*)(Y + row * 1024 + col) = w;
                    }
                }
        }
    }
};
struct EpiD {
    static constexpr bool PERM = true, AFTER_DRAIN = true;
    const float* x; float* out; const float* fng; float* xb; unsigned* cnt;
    __device__ __forceinline__ void operator()(const f32x4 (&)[2][2][4][2], const pg8::Unit&, int, int, int, int) const {}
    __device__ __forceinline__ void fused(f32x4 (&acc)[2][2][4][2], const pg8::Unit& u, int wr, int wc, int fr, int fq, LAS unsigned char* lds, int wid, int lane) const {
        const int tid = threadIdx.x;
        const int row0 = u.pm * 256 + wr * 64 + fr, col0 = u.pn * 256 + wc * 32 + 8 * fq;
        LAS float* P = (LAS float*)lds;
        LAS float* Sr = (LAS float*)(lds + 4096);
#pragma unroll
        for (int ai = 0; ai < 2; ++ai) {
            f32x4 xa[4][2], xc[4][2];
#pragma unroll
            for (int m = 0; m < 4; ++m)
#pragma unroll
                for (int bj = 0; bj < 2; ++bj) {
                    const size_t off = (size_t)(row0 + ai * 128 + m * 16) * 1024 + col0 + bj * 128;
                    xa[m][bj] = *(const f32x4*)(x + off); xc[m][bj] = *(const f32x4*)(x + off + 4);
                }
#pragma unroll
            for (int m = 0; m < 4; ++m) {
                float ss = 0.f;
#pragma unroll
                for (int bj = 0; bj < 2; ++bj) {
                    const f32x4 a = acc[ai][bj][m][0] + xa[m][bj], b = acc[ai][bj][m][1] + xc[m][bj];
                    acc[ai][bj][m][0] = a; acc[ai][bj][m][1] = b;
                    ss += (a[0] * a[0] + a[1] * a[1]) + (a[2] * a[2] + a[3] * a[3]) + (b[0] * b[0] + b[1] * b[1]) + (b[2] * b[2] + b[3] * b[3]);
                }
                ss += __shfl_xor(ss, 16); ss += __shfl_xor(ss, 32);
                if (fq == 0) P[(ai * 128 + wr * 64 + m * 16 + fr) * 4 + wc] = ss;
            }
        }
        __syncthreads();
        if (tid < 256) {
            const float t = (P[tid * 4] + P[tid * 4 + 1]) + (P[tid * 4 + 2] + P[tid * 4 + 3]);
            __hip_atomic_store(xb + ((size_t)(u.pm * 4 + u.pn)) * 256 + tid, t, __ATOMIC_RELAXED, __HIP_MEMORY_SCOPE_AGENT);
        }
        asm volatile("s_waitcnt vmcnt(0)" ::: "memory");
        __syncthreads();
        if (tid == 0) {
            unsigned* c = cnt + 64 * u.pm;
            (void)__hip_atomic_fetch_add(c, 1u, __ATOMIC_RELAXED, __HIP_MEMORY_SCOPE_AGENT);
            unsigned sp = 0;
            while (__hip_atomic_load(c, __ATOMIC_RELAXED, __HIP_MEMORY_SCOPE_AGENT) < 4u) { __builtin_amdgcn_s_sleep(2); if (++sp > (1u << 22)) break; }
            __builtin_amdgcn_fence(__ATOMIC_ACQUIRE, "agent");
            asm volatile("s_waitcnt vmcnt(0)" ::: "memory");
        }
        __syncthreads();
        if (tid < 256) {
            float t = 0.f;
#pragma unroll
            for (int pn = 0; pn < 4; ++pn) t += __hip_atomic_load(xb + ((size_t)(u.pm * 4 + pn)) * 256 + tid, __ATOMIC_RELAXED, __HIP_MEMORY_SCOPE_AGENT);
            Sr[tid] = __builtin_amdgcn_rsqf(t * (1.f / 1024.f) + RMS_EPS);
        }
        __syncthreads();
#pragma unroll
        for (int bj = 0; bj < 2; ++bj) {
            const f32x4 g0 = *(const f32x4*)(fng + col0 + bj * 128), g1 = *(const f32x4*)(fng + col0 + bj * 128 + 4);
#pragma unroll
            for (int ai = 0; ai < 2; ++ai)
#pragma unroll
                for (int m = 0; m < 4; ++m) {
                    const float rstd = Sr[ai * 128 + wr * 64 + m * 16 + fr];
                    const size_t off = (size_t)(row0 + ai * 128 + m * 16) * 1024 + col0 + bj * 128;
                    *(f32x4*)(out + off) = acc[ai][bj][m][0] * rstd * g0; *(f32x4*)(out + off + 4) = acc[ai][bj][m][1] * rstd * g1;
                }
        }
    }
};

__device__ __forceinline__ void p0_transpose_kn(const float* W, int K, int N, bf16_t* WT, int row_off, LAS float* scr, int kb, int nb, int lane) {
    const int k0 = 64 * kb, n0 = 32 * nb;
    float wv[32];
#pragma unroll
    for (int i = 0; i < 32; ++i) wv[i] = W[(size_t)(k0 + 2 * i + (lane >> 5)) * N + n0 + (lane & 31)];
#pragma unroll
    for (int i = 0; i < 32; ++i) scr[(2 * i + (lane >> 5)) * 33 + (lane & 31)] = wv[i];
    asm volatile("s_waitcnt lgkmcnt(0)" ::: "memory");
    const int c = lane & 7;
#pragma unroll
    for (int j = 0; j < 4; ++j) { const int n = (lane >> 3) + 8 * j; const LAS float* s = scr + (8 * c) * 33 + n;
        u32x4 o; o.x = pk2(s[0 * 33], s[1 * 33]); o.y = pk2(s[2 * 33], s[3 * 33]); o.z = pk2(s[4 * 33], s[5 * 33]); o.w = pk2(s[6 * 33], s[7 * 33]);
        *(u32x4*)(WT + (size_t)(row_off + n0 + n) * K + k0 + 8 * c) = o; }
    asm volatile("s_waitcnt lgkmcnt(0)" ::: "memory");
}

constexpr int SB_KW = 0, SB_VW = 69632, SB_ZS = 137216;
__device__ __forceinline__ void sb_unit(LAS unsigned char* lds, int unit, bf16_t* Q, const bf16_t* Kb, const bf16_t* VT) {
    const int tid = threadIdx.x, lane = tid & 63, w = tid >> 6, r = lane & 15, g = lane >> 4;
    const int bh = unit >> 6, qb = unit & 63, b = bh >> 3, h = bh & 7;
    const size_t rowbase = (size_t)b * SEQ;
    const int tblk = qb * 128, kwin0 = tblk >= 128 ? tblk - 128 : 0;
    LAS bf16_t* Kw = (LAS bf16_t*)(lds + SB_KW);
    LAS bf16_t* Vw = (LAS bf16_t*)(lds + SB_VW);
    LAS float* Zs = (LAS float*)(lds + SB_ZS) + w * (16 * 36);
    {
        u32x4 kv[8], vv[8];
#pragma unroll
        for (int i = 0; i < 8; ++i) { const int c = tid + 512 * i, key = c >> 4, dc = c & 15;
            kv[i] = *(const u32x4*)(Kb + (rowbase + kwin0 + key) * 1024 + h * 128 + 8 * dc); }
#pragma unroll
        for (int i = 0; i < 8; ++i) { const int c = tid + 512 * i, row = c >> 5, kc = c & 31;
            vv[i] = *(const u32x4*)(VT + ((size_t)(bh * 128 + row)) * 8192 + kwin0 + 8 * kc); }
        __syncthreads();
#pragma unroll
        for (int i = 0; i < 8; ++i) { const int c = tid + 512 * i, key = c >> 4, dc = c & 15; *(LAS u32x4*)(Kw + key * 136 + 8 * dc) = kv[i]; }
#pragma unroll
        for (int i = 0; i < 8; ++i) { const int c = tid + 512 * i, row = c >> 5, kc = c & 31; *(LAS u32x4*)(Vw + row * 264 + 8 * kc) = vv[i]; }
    }
    const int t0 = tblk + 16 * w;
    bf16x8 qf[4];
    {
        const bf16_t* qrow = Q + (rowbase + t0 + r) * 1024 + h * 128 + 8 * g;
#pragma unroll
        for (int kk = 0; kk < 4; ++kk) qf[kk] = *(const bf16x8*)(qrow + 32 * kk);
    }
    f32x4 o[8];
#pragma unroll
    for (int n = 0; n < 8; ++n) o[n] = (f32x4){0.f, 0.f, 0.f, 0.f};
    float sacc = 0.f;
    const int t_abs = t0 + r;
    const bf16_t* kbase = Kb + (rowbase + r) * 1024 + h * 128 + 8 * g;
    const bf16_t* vbase = VT + ((size_t)(bh * 128 + r)) * 8192 + 8 * g;
    __syncthreads();
    for (int kt = (t0 + 15) >> 5; kt >= 0; --kt) {
        const int key0 = 32 * kt;
        bf16x8 kf[8], vf[8];
        if (key0 >= kwin0) {
            const LAS bf16_t* kp = Kw + (key0 - kwin0 + r) * 136 + 8 * g;
            const LAS bf16_t* vp = Vw + r * 264 + (key0 - kwin0) + 8 * g;
#pragma unroll
            for (int n = 0; n < 2; ++n)
#pragma unroll
                for (int kk = 0; kk < 4; ++kk) kf[4 * n + kk] = *(const LAS bf16x8*)(kp + (16 * n) * 136 + 32 * kk);
#pragma unroll
            for (int n = 0; n < 8; ++n) vf[n] = *(const LAS bf16x8*)(vp + (16 * n) * 264);
        } else {
#pragma unroll
            for (int n = 0; n < 2; ++n)
#pragma unroll
                for (int kk = 0; kk < 4; ++kk) kf[4 * n + kk] = *(const bf16x8*)(kbase + (size_t)(key0 + 16 * n) * 1024 + 32 * kk);
#pragma unroll
            for (int n = 0; n < 8; ++n) vf[n] = *(const bf16x8*)(vbase + (size_t)(16 * n) * 8192 + key0);
        }
#pragma unroll
        for (int n = 0; n < 2; ++n) {
            f32x4 z = (f32x4){0.f, 0.f, 0.f, 0.f};
#pragma unroll
            for (int kk = 0; kk < 4; ++kk) z = __builtin_amdgcn_mfma_f32_16x16x32_bf16(qf[kk], kf[4 * n + kk], z, 0, 0, 0);
#pragma unroll
            for (int rg = 0; rg < 4; ++rg) Zs[(4 * g + rg) * 36 + 16 * n + r] = z[rg];
        }
        __builtin_amdgcn_wave_barrier();
        bf16x8 afr;
        {
            float zz[8], sp[8];
#pragma unroll
            for (int i = 0; i < 2; ++i) { const f32x4 v = *(const LAS f32x4*)(Zs + r * 36 + 8 * g + 4 * i); zz[4 * i] = v[0]; zz[4 * i + 1] = v[1]; zz[4 * i + 2] = v[2]; zz[4 * i + 3] = v[3]; }
            const int j0 = key0 + 8 * g;
            float run = 0.f;
#pragma unroll
            for (int i = 7; i >= 0; --i) {
                const bool valid = (j0 + i) < t_abs;
                const float s = fmaxf(zz[i], 0.f) + __logf(1.f + __expf(-fabsf(zz[i])));
                sp[i] = valid ? s : 0.f; zz[i] = zz[i] - s; run += sp[i];
            }
            const float tot = run;
            const float t1 = __shfl_xor(tot, 16), t2 = __shfl_xor(tot, 32), t3 = __shfl_xor(t1, 32);
            const float after = (g == 0) ? (t1 + t2 + t3) : (g == 1) ? (t2 + t3) : (g == 2) ? t1 : 0.f;
            float sub = after + sacc;
            unsigned pw[4];
#pragma unroll
            for (int i = 3; i >= 0; --i) {
                const bool v1 = (j0 + 2 * i + 1) < t_abs, v0 = (j0 + 2 * i) < t_abs;
                const float w1 = v1 ? __expf(zz[2 * i + 1] - sub) : 0.f; sub += sp[2 * i + 1];
                const float w0 = v0 ? __expf(zz[2 * i] - sub) : 0.f; sub += sp[2 * i];
                pw[i] = cvt_pk_bf16(w0, w1);
            }
            afr = __builtin_bit_cast(bf16x8, ((u32x4){pw[0], pw[1], pw[2], pw[3]}));
            sacc += tot + t1 + t2 + t3;
        }
        __builtin_amdgcn_wave_barrier();
#pragma unroll
        for (int n = 0; n < 8; ++n) o[n] = __builtin_amdgcn_mfma_f32_16x16x32_bf16(afr, vf[n], o[n], 0, 0, 0);
        float mn = sacc;
#pragma unroll
        for (int s = 1; s < 16; s <<= 1) mn = fminf(mn, __shfl_xor(mn, s));
        if (mn > 104.f) break;
    }
#pragma unroll
    for (int n = 0; n < 8; ++n)
#pragma unroll
        for (int rg = 0; rg < 4; ++rg)
            Q[(rowbase + t0 + 4 * g + rg) * 1024 + h * 128 + 16 * n + r] = (bf16_t)f2bf(o[n][rg]);
}

__device__ __forceinline__ void grp_arrive(unsigned* c) {
    asm volatile("s_waitcnt vmcnt(0)" ::: "memory");
    __syncthreads();
    if (threadIdx.x == 0) (void)__hip_atomic_fetch_add(c, 1u, __ATOMIC_RELAXED, __HIP_MEMORY_SCOPE_AGENT);
}
__device__ __forceinline__ void grp_wait(unsigned* c, unsigned target) {
    if (threadIdx.x == 0) {
        unsigned sp = 0;
        while (__hip_atomic_load(c, __ATOMIC_RELAXED, __HIP_MEMORY_SCOPE_AGENT) < target) { __builtin_amdgcn_s_sleep(2); if (++sp > (1u << 22)) break; }
        __builtin_amdgcn_fence(__ATOMIC_ACQUIRE, "agent");
        asm volatile("s_waitcnt vmcnt(0)" ::: "memory");
    }
    __syncthreads();
}

constexpr int HG_QT = 0, HG_KT = 17408, HG_KD = 34816, HG_VT = 53248, HG_AS = 71680, HG_SP = 80896, HG_PT = 115712, HG_DL = 117760, HG_DM = 118272;
struct HgRegs { float gv[16]; unsigned vv[16]; unsigned qv[16]; };
template <bool FULL>
__device__ __forceinline__ void hg_load(HgRegs& R, size_t m0, int h, const float* G, const bf16_t* HQ, const bf16_t* HI) {
    const int tid = threadIdx.x, k = tid & 127, part = tid >> 7;
    const size_t base = (m0 + 16 * part) * 1024 + h * 128 + k;
#pragma unroll
    for (int i = 0; i < 16; ++i) R.gv[i] = bf2f(((const bf16_t*)G)[base + (size_t)i * 1024]);
#pragma unroll
    for (int i = 0; i < 16; ++i) R.vv[i] = HI[base + (size_t)i * 1024];
    if (FULL) {
#pragma unroll
        for (int i = 0; i < 16; ++i) R.qv[i] = HQ[base + (size_t)i * 1024];
    }
}
template <bool FULL>
__device__ __forceinline__ float hg_prep(LAS unsigned char* lds, const HgRegs& R) {
    const int tid = threadIdx.x, k = tid & 127, part = tid >> 7;
    LAS float* ptot = (LAS float*)(lds + HG_PT);
    float gv[16], cs[16];
    float run = 0.f;
#pragma unroll
    for (int i = 0; i < 16; ++i) { gv[i] = R.gv[i]; run += gv[i]; cs[i] = run; }
    ptot[part * 128 + k] = run;
    unsigned vv[16];
#pragma unroll
    for (int i = 0; i < 16; ++i) vv[i] = R.vv[i];
    __syncthreads();
    const float p0 = ptot[k], p1 = ptot[128 + k], p2 = ptot[256 + k], p3 = ptot[384 + k];
    const float off = (part == 0) ? 0.f : (part == 1) ? p0 : (part == 2) ? (p0 + p1) : (p0 + p1 + p2);
    const float last = (p0 + p1) + (p2 + p3), mid = p0 + p1;
    LAS bf16_t* kdT = (LAS bf16_t*)(lds + HG_KD);
    LAS bf16_t* vT = (LAS bf16_t*)(lds + HG_VT);
    unsigned pk[8];
    float kkv[16], em[16];
    const float clm = __expf(last - mid);
#pragma unroll
    for (int i = 0; i < 16; ++i) { kkv[i] = 1.f - __expf(gv[i]); em[i] = __expf((FULL ? mid : last) - (cs[i] + off)); }
#pragma unroll
    for (int i = 0; i < 8; ++i) {
        const float a = kkv[2 * i] * em[2 * i] * (FULL ? clm : 1.f), c = kkv[2 * i + 1] * em[2 * i + 1] * (FULL ? clm : 1.f);
        pk[i] = cvt_pk_bf16(a, c);
    }
    *(LAS u32x4*)(kdT + k * 72 + 16 * part) = (u32x4){pk[0], pk[1], pk[2], pk[3]};
    *(LAS u32x4*)(kdT + k * 72 + 16 * part + 8) = (u32x4){pk[4], pk[5], pk[6], pk[7]};
    *(LAS u32x4*)(vT + k * 72 + 16 * part) = (u32x4){vv[0] | (vv[1] << 16), vv[2] | (vv[3] << 16), vv[4] | (vv[5] << 16), vv[6] | (vv[7] << 16)};
    *(LAS u32x4*)(vT + k * 72 + 16 * part + 8) = (u32x4){vv[8] | (vv[9] << 16), vv[10] | (vv[11] << 16), vv[12] | (vv[13] << 16), vv[14] | (vv[15] << 16)};
    if (FULL) {
        LAS bf16_t* qt = (LAS bf16_t*)(lds + HG_QT);
        LAS bf16_t* kt = (LAS bf16_t*)(lds + HG_KT);
#pragma unroll
        for (int i = 0; i < 16; ++i) {
            const float q = bf2f(R.qv[i]);
            qt[(16 * part + i) * 136 + k] = (bf16_t)f2bf(q * __builtin_amdgcn_rcpf(em[i]));
            kt[(16 * part + i) * 136 + k] = (bf16_t)f2bf(kkv[i] * em[i]);
        }
    }
    if (part == 0) { ((LAS float*)(lds + HG_DL))[k] = __expf(last); if (FULL) ((LAS float*)(lds + HG_DM))[k] = __expf(mid); }
    return last;
}
__device__ __forceinline__ void hg_state_update(LAS unsigned char* lds, f32x4 (&S)[8], int w, int r, int g) {
    const LAS bf16_t* kdT = (const LAS bf16_t*)(lds + HG_KD);
    const LAS bf16_t* vT = (const LAS bf16_t*)(lds + HG_VT);
    const LAS float* dl = (const LAS float*)(lds + HG_DL);
    const bf16x8 b0 = *(const LAS bf16x8*)(vT + (16 * w + r) * 72 + 8 * g), b1 = *(const LAS bf16x8*)(vT + (16 * w + r) * 72 + 32 + 8 * g);
#pragma unroll
    for (int i = 0; i < 8; ++i) {
        const f32x4 d = *(const LAS f32x4*)(dl + 16 * i + 4 * g);
        S[i] = S[i] * d;
        const bf16x8 a0 = *(const LAS bf16x8*)(kdT + (16 * i + r) * 72 + 8 * g), a1 = *(const LAS bf16x8*)(kdT + (16 * i + r) * 72 + 32 + 8 * g);
        S[i] = __builtin_amdgcn_mfma_f32_16x16x32_bf16(a0, b0, S[i], 0, 0, 0);
        S[i] = __builtin_amdgcn_mfma_f32_16x16x32_bf16(a1, b1, S[i], 0, 0, 0);
    }
}
__device__ __forceinline__ void hg_unit_a(LAS unsigned char* lds, int unit, const float* G, const bf16_t* HI, float* ST, float* DG, unsigned* cnt) {
    const int tid = threadIdx.x, lane = tid & 63, w = tid >> 6, r = lane & 15, g = lane >> 4;
    const int bh = unit >> 5, c = unit & 31, b = bh >> 3, h = bh & 7;
    f32x4 S[8];
#pragma unroll
    for (int i = 0; i < 8; ++i) S[i] = (f32x4){0.f, 0.f, 0.f, 0.f};
    float cumtot = 0.f;
    HgRegs R;
    const size_t mu = (size_t)b * SEQ + c * 256;
    hg_load<false>(R, mu, h, G, nullptr, HI);
    for (int sc = 0; sc < 4; ++sc) {
        __syncthreads();
        cumtot += hg_prep<false>(lds, R);
        if (sc < 3) hg_load<false>(R, mu + (sc + 1) * 64, h, G, nullptr, HI);
        __syncthreads();
        hg_state_update(lds, S, w, r, g);
    }
    float* U = ST + (size_t)unit * 16384;
#pragma unroll
    for (int i = 0; i < 8; ++i)
#pragma unroll
        for (int rg = 0; rg < 4; ++rg) __hip_atomic_store(&U[(16 * i + 4 * g + rg) * 128 + 16 * w + r], S[i][rg], __ATOMIC_RELAXED, __HIP_MEMORY_SCOPE_AGENT);
    if (tid < 128) __hip_atomic_store(&DG[unit * 128 + tid], __expf(cumtot), __ATOMIC_RELAXED, __HIP_MEMORY_SCOPE_AGENT);
    if (cnt) grp_arrive(cnt + 64 * bh);
}
__device__ __forceinline__ void hg_unit_c(LAS unsigned char* lds, int unit, const float* G, bf16_t* HQ, const bf16_t* HI, const float* ST, const float* ng) {
    const int tid = threadIdx.x, lane = tid & 63, w = tid >> 6, r = lane & 15, g = lane >> 4;
    const int bh = unit >> 5, c = unit & 31, b = bh >> 3, h = bh & 7;
    f32x4 S[8];
    {
        const float* U = ST + (size_t)unit * 16384;
#pragma unroll
        for (int i = 0; i < 8; ++i)
#pragma unroll
            for (int rg = 0; rg < 4; ++rg) S[i][rg] = U[(16 * i + 4 * g + rg) * 128 + 16 * w + r];
    }
    LAS bf16_t* qt = (LAS bf16_t*)(lds + HG_QT);
    LAS bf16_t* kt = (LAS bf16_t*)(lds + HG_KT);
    LAS bf16_t* vT = (LAS bf16_t*)(lds + HG_VT);
    LAS bf16_t* As = (LAS bf16_t*)(lds + HG_AS);
    LAS bf16_t* SpT = (LAS bf16_t*)(lds + HG_SP) + w * (16 * 136);
    LAS float* Os = (LAS float*)(lds + HG_QT);
    const LAS float* dm = (const LAS float*)(lds + HG_DM);
    HgRegs R;
    hg_load<true>(R, (size_t)b * SEQ + c * 256, h, G, HQ, HI);
    for (int sc = 0; sc < 4; ++sc) {
        const size_t m0 = (size_t)b * SEQ + c * 256 + sc * 64;
        __syncthreads();
        (void)hg_prep<true>(lds, R);
        if (sc < 3) hg_load<true>(R, m0 + 64, h, G, HQ, HI);
        __syncthreads();
#pragma unroll
        for (int i = 0; i < 8; ++i) {
            const f32x4 d = *(const LAS f32x4*)(dm + 16 * i + 4 * g);
            const f32x4 s = S[i] * d;
            *(LAS u32x2*)(SpT + r * 136 + 16 * i + 4 * g) = (u32x2){cvt_pk_bf16(s[0], s[1]), cvt_pk_bf16(s[2], s[3])};
        }
#pragma unroll
        for (int tt = 0; tt < 2; ++tt) {
            const int tile = 2 * w + tt, ti = tile >> 2, si = tile & 3;
            f32x4 a = (f32x4){0.f, 0.f, 0.f, 0.f};
            if (si <= ti) {
#pragma unroll
                for (int kk = 0; kk < 4; ++kk) {
                    const bf16x8 af = *(const LAS bf16x8*)(qt + (16 * ti + r) * 136 + 32 * kk + 8 * g);
                    const bf16x8 bf = *(const LAS bf16x8*)(kt + (16 * si + r) * 136 + 32 * kk + 8 * g);
                    a = __builtin_amdgcn_mfma_f32_16x16x32_bf16(af, bf, a, 0, 0, 0);
                }
            }
#pragma unroll
            for (int rg = 0; rg < 4; ++rg) {
                const int t = 16 * ti + 4 * g + rg, s = 16 * si + r;
                As[t * 72 + s] = (bf16_t)f2bf((s <= t) ? a[rg] : 0.f);
            }
        }
        __syncthreads();
        f32x4 o[4];
        {
            const bf16x8 vb0 = *(const LAS bf16x8*)(vT + (16 * w + r) * 72 + 8 * g), vb1 = *(const LAS bf16x8*)(vT + (16 * w + r) * 72 + 32 + 8 * g);
            bf16x8 sb[4];
#pragma unroll
            for (int kk = 0; kk < 4; ++kk) sb[kk] = *(const LAS bf16x8*)(SpT + r * 136 + 32 * kk + 8 * g);
#pragma unroll
            for (int ti = 0; ti < 4; ++ti) {
                f32x4 a = (f32x4){0.f, 0.f, 0.f, 0.f};
                const bf16x8 a0 = *(const LAS bf16x8*)(As + (16 * ti + r) * 72 + 8 * g), a1 = *(const LAS bf16x8*)(As + (16 * ti + r) * 72 + 32 + 8 * g);
                a = __builtin_amdgcn_mfma_f32_16x16x32_bf16(a0, vb0, a, 0, 0, 0);
                a = __builtin_amdgcn_mfma_f32_16x16x32_bf16(a1, vb1, a, 0, 0, 0);
#pragma unroll
                for (int kk = 0; kk < 4; ++kk) {
                    const bf16x8 qf = *(const LAS bf16x8*)(qt + (16 * ti + r) * 136 + 32 * kk + 8 * g);
                    a = __builtin_amdgcn_mfma_f32_16x16x32_bf16(qf, sb[kk], a, 0, 0, 0);
                }
                o[ti] = a;
            }
        }
        hg_state_update(lds, S, w, r, g);
        __syncthreads();
#pragma unroll
        for (int ti = 0; ti < 4; ++ti)
#pragma unroll
            for (int rg = 0; rg < 4; ++rg) Os[(16 * ti + 4 * g + rg) * 132 + 16 * w + r] = o[ti][rg];
        __syncthreads();
        {
            const int t = tid >> 3, sg = tid & 7;
            f32x4 v[4]; float ss = 0.f;
#pragma unroll
            for (int i = 0; i < 4; ++i) { v[i] = *(const LAS f32x4*)(Os + t * 132 + 16 * sg + 4 * i); ss += (v[i][0] * v[i][0] + v[i][1] * v[i][1]) + (v[i][2] * v[i][2] + v[i][3] * v[i][3]); }
            ss += __shfl_xor(ss, 1); ss += __shfl_xor(ss, 2); ss += __shfl_xor(ss, 4);
            const float rstd = __builtin_amdgcn_rsqf(ss * (1.f / 128.f) + RMS_EPS);
            const float* gp = ng + h * 128 + 16 * sg;
            unsigned pk[8];
#pragma unroll
            for (int i = 0; i < 4; ++i) {
                const f32x4 gg = *(const f32x4*)(gp + 4 * i);
                pk[2 * i] = cvt_pk_bf16(v[i][0] * rstd * gg[0], v[i][1] * rstd * gg[1]);
                pk[2 * i + 1] = cvt_pk_bf16(v[i][2] * rstd * gg[2], v[i][3] * rstd * gg[3]);
            }
            bf16_t* op = HQ + (m0 + t) * 1024 + h * 128 + 16 * sg;
            *(u32x4*)op = (u32x4){pk[0], pk[1], pk[2], pk[3]};
            *(u32x4*)(op + 8) = (u32x4){pk[4], pk[5], pk[6], pk[7]};
        }
    }
}

#define XB_TMO      128
#define XB_XCNT(j)  (256  + 64 * (j))
#define XB_XSUB(j)  (1280 + 64 * (j))
#define XB_XGEN(j)  (2304 + 64 * (j))
#define XB_TOP      3328
#define XB_TOPGEN   3392
#define XCD_BAR_WORDS 3456
#define XB_SPIN_CAP (1u << 18)
__device__ __forceinline__ unsigned xb_ld(unsigned* p)              { return __hip_atomic_load(p, __ATOMIC_RELAXED, __HIP_MEMORY_SCOPE_AGENT); }
__device__ __forceinline__ unsigned xb_add(unsigned* p, unsigned v) { return __hip_atomic_fetch_add(p, v, __ATOMIC_RELAXED, __HIP_MEMORY_SCOPE_AGENT); }
__device__ __forceinline__ unsigned xb_xcc_id() { return (unsigned)__builtin_amdgcn_s_getreg((3 << 11) | 20) & 0xFu; }
#define XB_SPIN(cond, bar) do { unsigned _sp = 0; while (cond) { __builtin_amdgcn_s_sleep(1); \
    if ((++_sp & 255u) == 0u) { if (xb_ld(&(bar)[XB_TMO])) break; if (_sp > XB_SPIN_CAP) { atomicAdd(&(bar)[XB_TMO], 1u); break; } } } } while (0)
struct XcdBarrier { unsigned* bar; unsigned x; volatile LAS unsigned* st; };
__device__ __forceinline__ XcdBarrier xcd_barrier_post(unsigned* bar, volatile LAS unsigned* st) {
    XcdBarrier b; b.bar = bar; b.x = xb_xcc_id(); b.st = st;
    if (threadIdx.x == 0) (void)xb_add(&bar[XB_XCNT(b.x)], 1u);
    return b;
}
__device__ __forceinline__ void xcd_barrier_complete(unsigned* bar, unsigned x, unsigned& nloc, unsigned& nx) {
    const unsigned G = gridDim.x * gridDim.y * gridDim.z;
    unsigned sum, cnt, mine, sp = 0u;
    for (;;) {
        sum = 0u; cnt = 0u; mine = 0u;
#pragma unroll
        for (unsigned j = 0; j < 16; ++j) { const unsigned c = xb_ld(&bar[XB_XCNT(j)]); sum += c; cnt += (c > 0u) ? 1u : 0u; mine = (j == x) ? c : mine; }
        if (sum == G) break;
        __builtin_amdgcn_s_sleep(1);
        if ((++sp & 255u) == 0u) { if (xb_ld(&bar[XB_TMO])) break; if (sp > XB_SPIN_CAP) { atomicAdd(&bar[XB_TMO], 1u); break; } }
    }
    nloc = mine > 0u ? mine : 1u; nx = cnt > 0u ? cnt : 1u;
}
__device__ __forceinline__ void xcd_barrier(const XcdBarrier& b) {
    asm volatile("s_waitcnt vmcnt(0)" ::: "memory");
    __syncthreads();
    if (threadIdx.x == 0) {
        unsigned* bar = b.bar;
        __builtin_amdgcn_s_waitcnt(0);
        unsigned nloc = b.st[0], nx = b.st[1];
        if (nloc == 0u) { xcd_barrier_complete(bar, b.x, nloc, nx); b.st[0] = nloc; b.st[1] = nx; }
        const unsigned old = xb_add(&bar[XB_XSUB(b.x)], 1u);
        const unsigned gen = old / nloc;
        if (old + 1u == (gen + 1u) * nloc) {
            __builtin_amdgcn_fence(__ATOMIC_RELEASE, "agent");
            asm volatile("s_waitcnt vmcnt(0)" ::: "memory");
            const unsigned og = xb_add(&bar[XB_TOP], 1u);
            const unsigned tg = og / nx;
            if (og + 1u == (tg + 1u) * nx) xb_add(&bar[XB_TOPGEN], 1u);
            else XB_SPIN(xb_ld(&bar[XB_TOPGEN]) == tg, bar);
            __builtin_amdgcn_fence(__ATOMIC_ACQUIRE, "agent");
            xb_add(&bar[XB_XGEN(b.x)], 1u);
            asm volatile("s_waitcnt vmcnt(0)" ::: "memory");
        } else {
            XB_SPIN(xb_ld(&bar[XB_XGEN(b.x)]) == gen, bar);
            __builtin_amdgcn_fence(__ATOMIC_ACQUIRE, "agent");
            asm volatile("s_waitcnt vmcnt(0)" ::: "memory");
        }
    }
    __syncthreads();
}

struct Args { const float* in[10]; float* out; unsigned char* ws; int ph_lo, ph_hi; };
__global__ void __launch_bounds__(512, 2) mk_fwd(Args args) {
    extern __shared__ __attribute__((aligned(16))) unsigned char lds_raw[];
    LAS unsigned char* lds = (LAS unsigned char*)lds_raw;
    cg::grid_group grid = cg::this_grid();
    const int tid = threadIdx.x, lane = tid & 63, wave = tid >> 6;
    const int G = gridDim.x, bid = blockIdx.x;
    unsigned char* ws = args.ws;
    const float* x = args.in[0]; const float* norm_g = args.in[1]; const float* w_in = args.in[2]; const float* b_gate = args.in[3];
    const float* lb_logits = args.in[4]; const float* hg_norm_g = args.in[5]; const float* w_sb = args.in[6]; const float* w_hg = args.in[7];
    const float* w_out = args.in[8]; const float* fng = args.in[9];
    float* out = args.out;
    bf16_t* Wt_in = (bf16_t*)(ws + WS_WIN); bf16_t* Wt_sbhg = (bf16_t*)(ws + WS_WSBHG); bf16_t* Wt_out = (bf16_t*)(ws + WS_WOUT);
    float* DG = (float*)(ws + WS_HGD);
    bf16_t* Hn = (bf16_t*)(ws + WS_H); bf16_t* SBQ = (bf16_t*)(ws + WS_SBQ); bf16_t* HGQ = (bf16_t*)(ws + WS_HGQ);
    bf16_t* SBK = (bf16_t*)(ws + WS_SBK); bf16_t* SBV = (bf16_t*)(ws + WS_SBV); bf16_t* HGI = (bf16_t*)(ws + WS_HGI);
    float* ST = (float*)(ws + WS_ST); bf16_t* GATES = (bf16_t*)(ws + WS_GATES); bf16_t* Y = (bf16_t*)(ws + WS_Y);
    float* Gf = out;
    const int lo = args.ph_lo, hi = args.ph_hi;
    if (lo < 0) grid.sync();
    if (tid < 16) ((LAS unsigned*)(lds + LDS_MISC))[tid] = 0u;
    __syncthreads();
    XcdBarrier bar = xcd_barrier_post((unsigned*)ws, (volatile LAS unsigned*)(lds + LDS_MISC));
#define IN(k) (lo <= (k) && (k) < hi)
#define SEAM(k) do { if (IN(k) && IN((k) + 1)) xcd_barrier(bar); } while (0)

    if (IN(0)) {
        LAS float* scr = (LAS float*)(lds + wave * 16384);
        const int gw = bid * 8 + wave, NGW = G * 8;
        for (int it = gw; it < 16 * 192; it += NGW) {
            const int kb = it / 192, j = it % 192, sg = j >> 5, seg = sg < 3 ? sg : sg + 1;
            p0_transpose_kn(w_in, 1024, 10240, Wt_in, 0, scr, kb, seg * 32 + (j & 31), lane);
        }
        for (int m4 = gw * 4; m4 < M_TOK; m4 += NGW * 4) {
            f32x4 v[4][4]; float s2[4];
#pragma unroll
            for (int q = 0; q < 4; ++q) { const f32x4* xr = (const f32x4*)(x + (size_t)(m4 + q) * 1024) + lane;
#pragma unroll
                for (int j = 0; j < 4; ++j) v[q][j] = xr[64 * j]; }
#pragma unroll
            for (int q = 0; q < 4; ++q) { s2[q] = 0.f;
#pragma unroll
                for (int j = 0; j < 4; ++j) s2[q] += (v[q][j][0] * v[q][j][0] + v[q][j][1] * v[q][j][1]) + (v[q][j][2] * v[q][j][2] + v[q][j][3] * v[q][j][3]); }
#pragma unroll
            for (int o = 1; o < 64; o <<= 1) {
#pragma unroll
                for (int q = 0; q < 4; ++q) s2[q] += __shfl_xor(s2[q], o); }
#pragma unroll
            for (int q = 0; q < 4; ++q) {
                const float rstd = __builtin_amdgcn_rsqf(s2[q] * (1.f / 1024.f) + RMS_EPS);
                u32x2* o8 = (u32x2*)(Hn + (size_t)(m4 + q) * 1024) + lane;
#pragma unroll
                for (int j = 0; j < 4; ++j) { const f32x4 gg = *((const f32x4*)norm_g + lane + 64 * j);
                    o8[64 * j] = (u32x2){pk2(v[q][j][0] * rstd * gg[0], v[q][j][1] * rstd * gg[1]), pk2(v[q][j][2] * rstd * gg[2], v[q][j][3] * rstd * gg[3])}; }
            }
        }
        __syncthreads();
    }
    SEAM(0);
    if (IN(1)) {
        pg8::Gemm g{Hn, Wt_in, M_TOK, 10240, 1024}; pg8::SegOrder S; S.init(G, bid, 0);
        EpiA E{SBQ, SBK, SBV, HGQ, HGI, Gf, lb_logits};
        pg8::gemm_phase<EpiA, pg8::SegOrder, true, true>(lds, g, S, E);
    }
    SEAM(1);
    const bool scan_in_p2 = (G == 256);
    unsigned* cntA = (unsigned*)(ws + 65536);
    unsigned* cntS = (unsigned*)(ws + 65536 + 4096);
    if (IN(2)) {
        for (int u = bid; u < 512; u += G) hg_unit_a(lds, u, Gf, HGI, ST, DG, scan_in_p2 ? cntA : nullptr);
        __syncthreads();
        for (int u = bid; u < 1024; u += G) sb_unit(lds, u, SBQ, SBK, SBV);
        __syncthreads();
        if (scan_in_p2) {
            grp_wait(cntA + 64 * (bid >> 5), 32u); grp_wait(cntA + 64 * ((bid >> 5) + 8), 32u);
#pragma unroll
            for (int j = 0; j < 2; ++j) {
                const int bh = (bid >> 5) + 8 * j;
                const int kv = (bid & 31) * 512 + tid, k = kv >> 7;
                float* stp = ST + ((size_t)(bh * 32) << 14) + kv;
                const float* dgp = DG + (bh * 32) * 128 + k;
                float u[32], d[32];
#pragma unroll
                for (int c = 0; c < 32; ++c) { u[c] = stp[(size_t)c << 14]; d[c] = dgp[c * 128]; }
                float S = 0.f;
#pragma unroll
                for (int c = 0; c < 32; ++c) { __hip_atomic_store(&stp[(size_t)c << 14], S, __ATOMIC_RELAXED, __HIP_MEMORY_SCOPE_AGENT); S = d[c] * S + u[c]; }
            }
            grp_arrive(cntS + 64 * (bid >> 5));
        }
    }
    if (!scan_in_p2) SEAM(2);
    if (IN(3) && !scan_in_p2) {
        for (int e = bid * 512 + tid; e < 16 * 16384; e += G * 512) {
            const int bh = e >> 14, kv = e & 16383, k = kv >> 7;
            float* stp = ST + ((size_t)(bh * 32) << 14) + kv;
            const float* dgp = DG + (bh * 32) * 128 + k;
            float u[32], d[32];
#pragma unroll
            for (int c = 0; c < 32; ++c) { u[c] = stp[(size_t)c << 14]; d[c] = dgp[c * 128]; }
            float S = 0.f;
#pragma unroll
            for (int c = 0; c < 32; ++c) { stp[(size_t)c << 14] = S; S = d[c] * S + u[c]; }
        }
    }
    if (IN(3) && IN(4) && !scan_in_p2) xcd_barrier(bar);
    if (IN(4)) {
        {
            LAS float* scr = (LAS float*)(lds + wave * 16384);
            const int gw = bid * 8 + wave, NGW = G * 8;
            for (int it = gw; it < 16 * 128 + 3 * 512; it += NGW) {
                int r = it;
                if (r < 16 * 128) { const int kb = r / 128, j = r % 128, sg = j >> 5, seg = sg == 0 ? 3 : sg + 6; p0_transpose_kn(w_in, 1024, 10240, Wt_in, 0, scr, kb, seg * 32 + (j & 31), lane); continue; } r -= 16 * 128;
                if (r < 512) { p0_transpose_kn(w_sb, 1024, 1024, Wt_sbhg, 0, scr, r / 32, r % 32, lane); continue; } r -= 512;
                if (r < 512) { p0_transpose_kn(w_hg, 1024, 1024, Wt_sbhg, 1024, scr, r / 32, r % 32, lane); continue; } r -= 512;
                p0_transpose_kn(w_out, 1024, 1024, Wt_out, 0, scr, r / 32, r % 32, lane);
            }
            __syncthreads();
        }
        if (scan_in_p2) grp_wait(cntS + 64 * (bid >> 5), 32u);
        for (int u = bid; u < 512; u += G) hg_unit_c(lds, u, Gf, HGQ, HGI, ST, hg_norm_g);
        __syncthreads();
    }
    SEAM(4);
    if (IN(5)) {
        pg8::Gemm g{Hn, Wt_in, M_TOK, 10240, 1024}; pg8::SegOrder S; S.init(G, bid, 1);
        EpiB E{SBQ, HGQ, GATES, b_gate};
        pg8::gemm_phase<EpiB, pg8::SegOrder, true, true>(lds, g, S, E);
    }
    SEAM(5);
    if (IN(6)) {
        pg8::Gemm g{SBQ, Wt_sbhg, 2 * M_TOK, 2048, 1024}; pg8::PairOrder S; S.init(G, bid);
        EpiC E{GATES, out, Y};
        pg8::gemm_phase<EpiC, pg8::PairOrder, true, true>(lds, g, S, E);
    }
    SEAM(6);
    if (IN(7)) {
        pg8::Gemm g{Y, Wt_out, M_TOK, 1024, 1024}; pg8::PlainOrder S; S.init(M_TOK, 1024, G, bid);
        EpiD E{x, out, fng, (float*)(ws + 131072), (unsigned*)(ws + 16384)};
        pg8::gemm_phase<EpiD, pg8::PlainOrder, true, true>(lds, g, S, E);
    }
#undef IN
#undef SEAM
}

#ifndef MK_N_LAUNCHES
#define MK_N_LAUNCHES 1
#endif
extern "C" void kernel_launch(void* const* d_in, const int* in_sizes, int n_in, void* d_out, int out_size, void* d_ws, size_t ws_size, hipStream_t stream) {
    static int grid = 0;
    if (grid == 0) {
        if (n_in != 10 || out_size != M_TOK * DM || ws_size < WS_END) { fprintf(stderr, "kernel_launch: unexpected shapes (n_in %d out %d ws %zu)\n", n_in, out_size, ws_size); grid = -1; return; }
        int dev = 0, cus = 0, per_cu = 0;
        (void)hipGetDevice(&dev);
        (void)hipDeviceGetAttribute(&cus, hipDeviceAttributeMultiprocessorCount, dev);
        if (hipFuncSetAttribute((const void*)mk_fwd, hipFuncAttributeMaxDynamicSharedMemorySize, LDS_BYTES) != hipSuccess) { fprintf(stderr, "kernel_launch: hipFuncSetAttribute failed\n"); grid = -1; return; }
        if (hipOccupancyMaxActiveBlocksPerMultiprocessor(&per_cu, (const void*)mk_fwd, 512, LDS_BYTES) != hipSuccess || per_cu < 1) { fprintf(stderr, "kernel_launch: occupancy query says %d\n", per_cu); per_cu = 1; }
        (void)hipGetLastError();
        grid = cus > 0 ? cus : 256;
    }
    if (grid < 0) return;
    if (hipMemsetAsync(d_ws, 0, 65536 + 8192, stream) != hipSuccess) { fprintf(stderr, "kernel_launch: memset failed\n"); return; }
    Args a{};
    for (int i = 0; i < 10; ++i) a.in[i] = (const float*)d_in[i];
    a.out = (float*)d_out; a.ws = (unsigned char*)d_ws;
#if MK_N_LAUNCHES == 1
    a.ph_lo = 0; a.ph_hi = 8;
    void* kargs[] = {&a};
    hipError_t e = hipLaunchCooperativeKernel((const void*)mk_fwd, dim3(grid), dim3(512), kargs, LDS_BYTES, stream);
    if (e != hipSuccess) fprintf(stderr, "kernel_launch: cooperative launch failed: %s (grid %d)\n", hipGetErrorString(e), grid);
#else
    for (int p = 0; p < 8; ++p) { a.ph_lo = p; a.ph_hi = p + 1; hipLaunchKernelGGL(mk_fwd, dim3(grid), dim3(512), LDS_BYTES, stream, a); }
#endif
}
```

```cpp
#include <hip/hip_runtime.h>
#include <hip/hip_cooperative_groups.h>
#include <cstdio>
#include <cstdint>
namespace cg = cooperative_groups;

#define LAS __attribute__((address_space(3)))
typedef unsigned short bf16_t;
typedef short bf16x8 __attribute__((ext_vector_type(8)));
typedef float f32x4 __attribute__((ext_vector_type(4)));
typedef unsigned u32x4 __attribute__((ext_vector_type(4)));
typedef unsigned u32x2 __attribute__((ext_vector_type(2)));

namespace pg8 {
constexpr int BM = 256, BK = 64, HALF = 128, HTB = HALF * BK * 2, STAGE_BYTES = 8 * HTB, NXCD = 8, WGM = 8;
__host__ __device__ __forceinline__ int lds_byte(int r, int c) { const int st = (r >> 4) * 2 + (c >> 5), rr = r & 15, cc = c & 31, ob = rr * 64 + cc * 2; return st * 1024 + (ob ^ (((ob >> 9) & 1) << 5)); }
__host__ __device__ __forceinline__ void stage_rc(int b, int& R, int& C) { const int st = b / 1024, sb = b % 1024, swz = sb ^ (((sb >> 9) & 1) << 5); R = (st >> 1) * 16 + swz / 64; C = (st & 1) * 32 + (swz % 64) / 2; }
__host__ __device__ __forceinline__ int perm32(int rho) { const int n = rho >> 4, i = rho & 15; return 8 * (i >> 2) + 4 * n + (i & 3); }

struct Unit { int pm, pn; };
struct Gemm { const bf16_t* A; const bf16_t* Bt; int M, N, K; };

struct StaticOrder {
    int nM, nN, nwg, G, c;
    __host__ __device__ void init(int M, int N, int G_, int c_) { nM = M / BM; nN = N / BM; nwg = nM * nN; G = G_; c = c_; }
    __host__ __device__ bool next(int i, Unit& u) const {
        const long L = (long)i * G + c; if (L >= nwg) return false;
        int wgid = (int)L; { const int q = nwg / NXCD, r = nwg % NXCD, xcd = wgid % NXCD, off = wgid / NXCD; wgid = (xcd < r ? xcd * (q + 1) : r * (q + 1) + (xcd - r) * q) + off; }
        const int nig = WGM * nN, gid = wgid / nig, fm = gid * WGM, gsz = (nM - fm) < WGM ? (nM - fm) : WGM;
        u.pm = fm + ((wgid % nig) % gsz); u.pn = (wgid % nig) / gsz; return true;
    }
};
struct SegOrder {
    StaticOrder so; int mode;
    __device__ void init(int G, int c, int mode_) { mode = mode_; so.init(16384, (mode_ == 0 ? 24 : 16) * 256, G, c); }
    __device__ bool next(int i, Unit& u) const {
        if (!so.next(i, u)) return false;
        if (mode == 0) u.pn = (u.pn < 12) ? u.pn : u.pn + 4; else u.pn = (u.pn < 4) ? u.pn + 12 : u.pn + 24;
        return true;
    }
    __device__ __forceinline__ void a_ready(const Unit&) const {}
    __device__ __forceinline__ void done(const Unit&) const {}
};
struct PairOrder {
    StaticOrder so;
    __device__ void init(int G, int c) { so.init(16384, 1024, G, c); }
    __device__ bool next(int i, Unit& u) const { if (!so.next(i >> 1, u)) return false; u.pm += 64 * (i & 1); u.pn += 4 * (i & 1); return true; }
    __device__ __forceinline__ void a_ready(const Unit&) const {}
    __device__ __forceinline__ void done(const Unit&) const {}
};
struct PlainOrder {
    StaticOrder so;
    __device__ void init(int M, int N, int G, int c) { so.init(M, N, G, c); }
    __device__ bool next(int i, Unit& u) const { return so.next(i, u); }
    __device__ __forceinline__ void a_ready(const Unit&) const {}
    __device__ __forceinline__ void done(const Unit&) const {}
};

typedef float f32x2_t __attribute__((ext_vector_type(2)));
typedef __bf16 bf16x2_t __attribute__((ext_vector_type(2)));
__device__ __forceinline__ unsigned cvt_pk_bf16(float lo, float hi) { f32x2_t v = {lo, hi}; bf16x2_t b = __builtin_convertvector(v, bf16x2_t); return __builtin_bit_cast(unsigned, b); }

template <class Epi, class Sched, bool ALIGN_EPI = false, bool SP2 = false>
__device__ __forceinline__ void gemm_phase(LAS unsigned char* lds, const Gemm g, const Sched& S, const Epi& E) {
    const int tid = threadIdx.x, wid = __builtin_amdgcn_readfirstlane(tid >> 6), lane = tid & 63, wr = wid >> 2, wc = wid & 3, fr = lane & 15, fq = lane >> 4;
    const int K = g.K, nt = K / BK;
    unsigned voffA[2], voffB[2];
#pragma unroll
    for (int i = 0; i < 2; ++i) { int R, C; stage_rc(tid * 16 + i * 8192, R, C); const int Rb = Epi::PERM ? ((R & ~31) + perm32(R & 31)) : R;
        voffA[i] = (unsigned)(R * K + C) * 2u; voffB[i] = (unsigned)(Rb * K + C) * 2u; }
    const size_t kstep = (size_t)(BK * 2);
    const size_t hstep = (size_t)HALF * K * 2;
    const size_t tstep = 2 * hstep;
    const unsigned ldsw = (unsigned)wid * 1024u;
    const int aoff = lds_byte(wr * 64 + fr, fq * 8), boff = lds_byte(wc * 32 + fr, fq * 8);
#define PG8_SA(b, h) (((b) * 2 + (h)) * HTB)
#define PG8_SB(b, h) ((4 + (b) * 2 + (h)) * HTB)
#define PG8_STAGE(bufoff, gbase, voff) do { _Pragma("unroll") for (int _i = 0; _i < 2; ++_i) \
        __builtin_amdgcn_global_load_lds((const unsigned*)((const char*)(gbase) + (voff)[_i]), (LAS unsigned*)(lds + (bufoff) + ldsw + _i * 8192), 16, 0, 0); } while (0)
#define PG8_LDA(dst, b, h) do { _Pragma("unroll") for (int m = 0; m < 4; ++m) _Pragma("unroll") for (int k = 0; k < 2; ++k) dst[m][k] = *(const LAS bf16x8*)(lds + PG8_SA(b, h) + aoff + m * 2048 + k * 1024); } while (0)
#define PG8_LDB(dst, b, h) do { _Pragma("unroll") for (int n = 0; n < 2; ++n) _Pragma("unroll") for (int k = 0; k < 2; ++k) dst[n][k] = *(const LAS bf16x8*)(lds + PG8_SB(b, h) + boff + n * 2048 + k * 1024); } while (0)
#define PG8_MMA(ai, bj, At, Bt) do { __builtin_amdgcn_s_setprio(1); _Pragma("unroll") for (int m = 0; m < 4; ++m) _Pragma("unroll") for (int n = 0; n < 2; ++n) _Pragma("unroll") for (int k = 0; k < 2; ++k) \
        acc[ai][bj][m][n] = __builtin_amdgcn_mfma_f32_16x16x32_bf16(Bt[n][k], At[m][k], acc[ai][bj][m][n], 0, 0, 0); __builtin_amdgcn_s_setprio(0); } while (0)
#define PG8_WAIT_V(n) asm volatile("s_waitcnt vmcnt(" #n ")" ::: "memory")
#define PG8_WAIT_L(n) asm volatile("s_waitcnt lgkmcnt(" #n ")" ::: "memory")
#define PG8_BAR __builtin_amdgcn_s_barrier()
#define PG8_SCHED __builtin_amdgcn_sched_barrier(0)
    Unit cur, nxt; int ui = 0;
    if (!S.next(0, cur)) return;
    f32x4 acc[2][2][4][2];
#pragma unroll
    for (int a = 0; a < 2; ++a)
#pragma unroll
        for (int b = 0; b < 2; ++b)
#pragma unroll
            for (int m = 0; m < 4; ++m)
#pragma unroll
                for (int n = 0; n < 2; ++n) acc[a][b][m][n] = (f32x4){0.f, 0.f, 0.f, 0.f};
    bf16x8 At[4][2], B0[2][2], B1[2][2];
    const char* cA = (const char*)g.A + (size_t)cur.pm * tstep; const char* cB = (const char*)g.Bt + (size_t)cur.pn * tstep;
    S.a_ready(cur);
    if constexpr (SP2) {
        PG8_STAGE(PG8_SB(0, 0), cB, voffB); PG8_STAGE(PG8_SB(0, 1), cB + hstep, voffB); PG8_STAGE(PG8_SA(0, 0), cA, voffA); PG8_STAGE(PG8_SA(0, 1), cA + hstep, voffA);
        if (wr == 1) PG8_BAR;
        PG8_WAIT_V(2); PG8_BAR;
        PG8_STAGE(PG8_SB(1, 0), cB + kstep, voffB); PG8_STAGE(PG8_SA(1, 0), cA + kstep, voffA); PG8_STAGE(PG8_SB(1, 1), cB + hstep + kstep, voffB);
        PG8_WAIT_V(6); PG8_BAR;
    } else {
        PG8_STAGE(PG8_SB(0, 0), cB, voffB); PG8_STAGE(PG8_SA(0, 0), cA, voffA); PG8_STAGE(PG8_SB(0, 1), cB + hstep, voffB); PG8_STAGE(PG8_SA(0, 1), cA + hstep, voffA);
        if (wr == 1) PG8_BAR;
        PG8_WAIT_V(4); PG8_BAR;
        PG8_STAGE(PG8_SB(1, 0), cB + kstep, voffB); PG8_STAGE(PG8_SA(1, 0), cA + kstep, voffA); PG8_STAGE(PG8_SB(1, 1), cB + hstep + kstep, voffB);
        PG8_WAIT_V(6); PG8_BAR;
    }
    for (;;) {
        const bool has_next = S.next(ui + 1, nxt);
        const char* nA = has_next ? (const char*)g.A + (size_t)nxt.pm * tstep : cA; const char* nB = has_next ? (const char*)g.Bt + (size_t)nxt.pn * tstep : cB;
        for (int t = 0; t < nt; t += 2) {
            const bool last = (t == nt - 2);
            const char* a1 = cA + (size_t)(t + 1) * kstep;
            const char* a2 = last ? nA : cA + (size_t)(t + 2) * kstep; const char* b2 = last ? nB : cB + (size_t)(t + 2) * kstep;
            const char* a3 = a2 + kstep; const char* b3 = b2 + kstep;
            if (last && has_next) S.a_ready(nxt);
            if constexpr (SP2) {
            PG8_LDB(B0, 0, 0); PG8_LDB(B1, 0, 1); PG8_SCHED; PG8_LDA(At, 0, 0); PG8_STAGE(PG8_SA(1, 1), a1 + hstep, voffA);
            PG8_WAIT_V(8); PG8_WAIT_L(0); PG8_BAR; PG8_MMA(0, 0, At, B0); PG8_MMA(0, 1, At, B1); PG8_BAR; PG8_SCHED;
            PG8_LDA(At, 0, 1); PG8_STAGE(PG8_SB(0, 0), b2, voffB); PG8_STAGE(PG8_SB(0, 1), b2 + hstep, voffB); PG8_STAGE(PG8_SA(0, 0), a2, voffA);
            PG8_WAIT_V(8); PG8_WAIT_L(0); PG8_BAR; PG8_MMA(1, 0, At, B0); PG8_MMA(1, 1, At, B1); PG8_BAR; PG8_SCHED;
            PG8_LDB(B0, 1, 0); PG8_LDB(B1, 1, 1); PG8_SCHED; PG8_LDA(At, 1, 0); PG8_STAGE(PG8_SA(0, 1), a2 + hstep, voffA);
            PG8_WAIT_V(8); PG8_WAIT_L(0); PG8_BAR; PG8_MMA(0, 0, At, B0); PG8_MMA(0, 1, At, B1); PG8_BAR; PG8_SCHED;
            PG8_LDA(At, 1, 1); PG8_STAGE(PG8_SB(1, 0), b3, voffB); PG8_STAGE(PG8_SB(1, 1), b3 + hstep, voffB); PG8_STAGE(PG8_SA(1, 0), a3, voffA);
            PG8_WAIT_V(8); PG8_WAIT_L(0); PG8_BAR; PG8_MMA(1, 0, At, B0); PG8_MMA(1, 1, At, B1); PG8_BAR; PG8_SCHED;
            } else {
            PG8_LDB(B0, 0, 0); PG8_SCHED; PG8_LDA(At, 0, 0); PG8_STAGE(PG8_SA(1, 1), a1 + hstep, voffA);
            PG8_WAIT_L(8); PG8_BAR; PG8_WAIT_L(0); PG8_MMA(0, 0, At, B0); PG8_BAR; PG8_SCHED;
            PG8_LDB(B1, 0, 1); PG8_STAGE(PG8_SB(0, 0), b2, voffB);
            PG8_BAR; PG8_WAIT_L(0); PG8_MMA(0, 1, At, B1); PG8_BAR;
            PG8_LDA(At, 0, 1); PG8_STAGE(PG8_SA(0, 0), a2, voffA);
            PG8_BAR; PG8_WAIT_L(0); PG8_MMA(1, 0, At, B0); PG8_BAR; PG8_SCHED;
            PG8_STAGE(PG8_SB(0, 1), b2 + hstep, voffB);
            PG8_WAIT_V(6); PG8_BAR; PG8_MMA(1, 1, At, B1); PG8_BAR;
            PG8_LDB(B0, 1, 0); PG8_SCHED; PG8_LDA(At, 1, 0); PG8_STAGE(PG8_SA(0, 1), a2 + hstep, voffA);
            PG8_WAIT_L(8); PG8_BAR; PG8_WAIT_L(0); PG8_MMA(0, 0, At, B0); PG8_BAR; PG8_SCHED;
            PG8_LDB(B1, 1, 1); PG8_STAGE(PG8_SB(1, 0), b3, voffB);
            PG8_BAR; PG8_WAIT_L(0); PG8_MMA(0, 1, At, B1); PG8_BAR;
            PG8_LDA(At, 1, 1); PG8_STAGE(PG8_SA(1, 0), a3, voffA);
            PG8_BAR; PG8_WAIT_L(0); PG8_MMA(1, 0, At, B0); PG8_BAR; PG8_SCHED;
            PG8_STAGE(PG8_SB(1, 1), b3 + hstep, voffB);
            PG8_WAIT_V(6); PG8_BAR; PG8_MMA(1, 1, At, B1); PG8_BAR;
            }
        }
        if constexpr (ALIGN_EPI) { if (wr == 0) PG8_BAR; }
        if constexpr (!Epi::AFTER_DRAIN) { E(acc, cur, wr, wc, fr, fq); S.done(cur); }
        if (!has_next) break;
#pragma unroll
        for (int a = 0; a < 2; ++a)
#pragma unroll
            for (int b = 0; b < 2; ++b)
#pragma unroll
                for (int m = 0; m < 4; ++m)
#pragma unroll
                    for (int n = 0; n < 2; ++n) acc[a][b][m][n] = (f32x4){0.f, 0.f, 0.f, 0.f};
        cur = nxt; cA = nA; cB = nB; ++ui;
        if constexpr (ALIGN_EPI) { if (wr == 1) PG8_BAR; }
    }
    PG8_WAIT_V(0);
    if constexpr (!ALIGN_EPI) { if (wr == 0) PG8_BAR; }
    PG8_BAR;
    if constexpr (Epi::AFTER_DRAIN) { E.fused(acc, cur, wr, wc, fr, fq, lds, wid, lane); S.done(cur); }
#undef PG8_SA
#undef PG8_SB
#undef PG8_STAGE
#undef PG8_LDA
#undef PG8_LDB
#undef PG8_MMA
#undef PG8_WAIT_V
#undef PG8_WAIT_L
#undef PG8_BAR
#undef PG8_SCHED
}
}
using pg8::cvt_pk_bf16;

constexpr int M_TOK = 16384, DM = 1024, SEQ = 8192;
constexpr size_t MiB = 1u << 20;
constexpr size_t WS_ROWSQ = 128 * 1024;
constexpr size_t WS_WIN = 1 * MiB;
constexpr size_t WS_WSBHG = 21 * MiB;
constexpr size_t WS_WOUT = 25 * MiB;
constexpr size_t WS_HGD = 27 * MiB;
constexpr size_t WS_H = 28 * MiB;
constexpr size_t WS_SBQ = 60 * MiB;
constexpr size_t WS_HGQ = 92 * MiB;
constexpr size_t WS_SBK = 124 * MiB;
constexpr size_t WS_SBV = 156 * MiB;
constexpr size_t WS_HGI = 188 * MiB;
constexpr size_t WS_ST = 220 * MiB;
constexpr size_t WS_GATES = 124 * MiB;
constexpr size_t WS_Y = 188 * MiB;
constexpr size_t WS_END = 252 * MiB;
constexpr int LDS_BYTES = 163840, LDS_MISC = 163840 - 64;
constexpr float RMS_EPS = 1e-6f;

__device__ __forceinline__ float bf2f(unsigned u) { return __uint_as_float(u << 16); }
__device__ __forceinline__ unsigned f2bf(float f) { unsigned u = __float_as_uint(f); return (u + 0x7fffu + ((u >> 16) & 1u)) >> 16; }
__device__ __forceinline__ unsigned pk2(float lo, float hi) { return f2bf(lo) | (f2bf(hi) << 16); }
__device__ __forceinline__ float sigmoidf_(float v) { return __builtin_amdgcn_rcpf(1.f + __expf(-v)); }
__device__ __forceinline__ float siluf_(float v) { return v * sigmoidf_(v); }
__device__ __forceinline__ float wave_sum(float v) {
#pragma unroll
    for (int o = 1; o < 64; o <<= 1) v += __shfl_xor(v, o);
    return v;
}

struct EpiA {
    static constexpr bool AFTER_DRAIN = false;
    static constexpr bool PERM = true;
    bf16_t* sbq; bf16_t* sbk; bf16_t* sbv; bf16_t* hgq; bf16_t* hgi; float* G; const float* lbl;
    __device__ __forceinline__ void operator()(const f32x4 (&acc)[2][2][4][2], const pg8::Unit& u, int wr, int wc, int fr, int fq) const {
        const int seg = u.pn >> 2;
        const int row0 = u.pm * 256 + wr * 64 + fr, col0 = (u.pn & 3) * 256 + wc * 32 + 8 * fq;
        if (seg == 5) {
#pragma unroll
            for (int bj = 0; bj < 2; ++bj) {
                const int col = col0 + bj * 128;
                float lb[8];
#pragma unroll
                for (int j = 0; j < 8; ++j) lb[j] = __builtin_amdgcn_rcpf(1.f + __expf(lbl[1024 + col + j] - lbl[col + j]));
#pragma unroll
                for (int ai = 0; ai < 2; ++ai)
#pragma unroll
                    for (int m = 0; m < 4; ++m) {
                        bf16_t* p = (bf16_t*)G + (size_t)(row0 + ai * 128 + m * 16) * 1024 + col;
                        f32x4 a = acc[ai][bj][m][0], b = acc[ai][bj][m][1], ga, gb;
#pragma unroll
                        for (int j = 0; j < 4; ++j) { ga[j] = __logf(lb[j] + (1.f - lb[j]) * sigmoidf_(a[j])); gb[j] = __logf(lb[4 + j] + (1.f - lb[4 + j]) * sigmoidf_(b[j])); }
                        u32x4 w; w.x = cvt_pk_bf16(ga[0], ga[1]); w.y = cvt_pk_bf16(ga[2], ga[3]); w.z = cvt_pk_bf16(gb[0], gb[1]); w.w = cvt_pk_bf16(gb[2], gb[3]);
                        *(u32x4*)p = w;
                    }
            }
        } else {
            if (seg == 2) {
#pragma unroll
                for (int ai = 0; ai < 2; ++ai)
#pragma unroll
                    for (int m = 0; m < 4; ++m) {
                        const int row = row0 + ai * 128 + m * 16, bb = row >> 13, ss = row & 8191;
#pragma unroll
                        for (int bj = 0; bj < 2; ++bj) {
                            const int col = col0 + bj * 128;
                            bf16_t* p = sbv + ((size_t)(bb * 1024 + col)) * 8192 + ss;
                            const f32x4 a = acc[ai][bj][m][0], b = acc[ai][bj][m][1];
#pragma unroll
                            for (int j = 0; j < 4; ++j) { p[(size_t)j * 8192] = (bf16_t)f2bf(a[j]); p[(size_t)(4 + j) * 8192] = (bf16_t)f2bf(b[j]); }
                        }
                    }
                return;
            }
            bf16_t* base = seg == 0 ? sbq : seg == 1 ? sbk : seg == 2 ? sbv : seg == 4 ? hgq : hgi;
            const float sc = seg == 0 ? 0.08838834764831845f : 1.f; const bool act = seg == 4;
#pragma unroll
            for (int ai = 0; ai < 2; ++ai)
#pragma unroll
                for (int m = 0; m < 4; ++m)
#pragma unroll
                    for (int bj = 0; bj < 2; ++bj) {
                        f32x4 a = acc[ai][bj][m][0], b = acc[ai][bj][m][1];
                        if (act) {
#pragma unroll
                            for (int j = 0; j < 4; ++j) { a[j] = siluf_(a[j]); b[j] = siluf_(b[j]); } }
                        a = a * sc; b = b * sc;
                        u32x4 w; w.x = cvt_pk_bf16(a[0], a[1]); w.y = cvt_pk_bf16(a[2], a[3]); w.z = cvt_pk_bf16(b[0], b[1]); w.w = cvt_pk_bf16(b[2], b[3]);
                        *(u32x4*)(base + (size_t)(row0 + ai * 128 + m * 16) * 1024 + col0 + bj * 128) = w;
                    }
        }
    }
};
struct EpiB {
    static constexpr bool AFTER_DRAIN = false;
    static constexpr bool PERM = true;
    bf16_t* asb; bf16_t* ahg; bf16_t* gates; const float* bgate;
    __device__ __forceinline__ void operator()(const f32x4 (&acc)[2][2][4][2], const pg8::Unit& u, int wr, int wc, int fr, int fq) const {
        const int seg = u.pn >> 2;
        const int row0 = u.pm * 256 + wr * 64 + fr, col0 = (u.pn & 3) * 256 + wc * 32 + 8 * fq;
        if (seg >= 8) {
#pragma unroll
            for (int bj = 0; bj < 2; ++bj) {
                const int col = (seg - 8) * 1024 + col0 + bj * 128;
                const f32x4 b0 = *(const f32x4*)(bgate + col), b1 = *(const f32x4*)(bgate + col + 4);
#pragma unroll
                for (int ai = 0; ai < 2; ++ai)
#pragma unroll
                    for (int m = 0; m < 4; ++m) {
                        f32x4 a = acc[ai][bj][m][0] + b0, b = acc[ai][bj][m][1] + b1;
#pragma unroll
                        for (int j = 0; j < 4; ++j) { a[j] = sigmoidf_(a[j]); b[j] = sigmoidf_(b[j]); }
                        u32x4 w; w.x = cvt_pk_bf16(a[0], a[1]); w.y = cvt_pk_bf16(a[2], a[3]); w.z = cvt_pk_bf16(b[0], b[1]); w.w = cvt_pk_bf16(b[2], b[3]);
                        *(u32x4*)(gates + (size_t)(row0 + ai * 128 + m * 16) * 2048 + col) = w;
                    }
            }
        } else {
            bf16_t* base = seg == 3 ? asb : ahg;
#pragma unroll
            for (int ai = 0; ai < 2; ++ai) {
                u32x4 ov[4][2];
#pragma unroll
                for (int m = 0; m < 4; ++m)
#pragma unroll
                    for (int bj = 0; bj < 2; ++bj) ov[m][bj] = *(const u32x4*)(base + (size_t)(row0 + ai * 128 + m * 16) * 1024 + col0 + bj * 128);
#pragma unroll
                for (int m = 0; m < 4; ++m)
#pragma unroll
                    for (int bj = 0; bj < 2; ++bj) {
                        const u32x4 o = ov[m][bj];
                        const f32x4 a = acc[ai][bj][m][0], b = acc[ai][bj][m][1];
                        u32x4 w;
                        w.x = cvt_pk_bf16(bf2f(o.x & 0xffffu) * siluf_(a[0]), bf2f(o.x >> 16) * siluf_(a[1]));
                        w.y = cvt_pk_bf16(bf2f(o.y & 0xffffu) * siluf_(a[2]), bf2f(o.y >> 16) * siluf_(a[3]));
                        w.z = cvt_pk_bf16(bf2f(o.z & 0xffffu) * siluf_(b[0]), bf2f(o.z >> 16) * siluf_(b[1]));
                        w.w = cvt_pk_bf16(bf2f(o.w & 0xffffu) * siluf_(b[2]), bf2f(o.w >> 16) * siluf_(b[3]));
                        *(u32x4*)(base + (size_t)(row0 + ai * 128 + m * 16) * 1024 + col0 + bj * 128) = w;
                    }
            }
        }
    }
};
struct EpiC {
    static constexpr bool AFTER_DRAIN = false;
    static constexpr bool PERM = true;
    const bf16_t* gates; float* tmp; bf16_t* Y;
    __device__ __forceinline__ void operator()(const f32x4 (&acc)[2][2][4][2], const pg8::Unit& u, int wr, int wc, int fr, int fq) const {
        const bool second = u.pm >= 64;
        const int pm = second ? u.pm - 64 : u.pm, pn = second ? u.pn - 4 : u.pn;
        const int row0 = pm * 256 + wr * 64 + fr, col0 = pn * 256 + wc * 32 + 8 * fq;
#pragma unroll
        for (int ai = 0; ai < 2; ++ai)
#pragma unroll
        for (int mh = 0; mh < 2; ++mh) {
            u32x4 gv[2][2], tv[2][2];
#pragma unroll
            for (int mm = 0; mm < 2; ++mm)
#pragma unroll
                for (int bj = 0; bj < 2; ++bj) {
                    const size_t row = (size_t)(row0 + ai * 128 + (2 * mh + mm) * 16); const int col = col0 + bj * 128;
                    gv[mm][bj] = *(const u32x4*)(gates + row * 2048 + (second ? 1024 : 0) + col);
                    if (second) tv[mm][bj] = *(const u32x4*)((const bf16_t*)tmp + row * 1024 + col);
                }
#pragma unroll
            for (int mm = 0; mm < 2; ++mm)
#pragma unroll
                for (int bj = 0; bj < 2; ++bj) {
                    const int m = 2 * mh + mm;
                    const size_t row = (size_t)(row0 + ai * 128 + m * 16); const int col = col0 + bj * 128;
                    const u32x4 gt = gv[mm][bj];
                    f32x4 a = acc[ai][bj][m][0], b = acc[ai][bj][m][1];
                    a[0] *= bf2f(gt.x & 0xffffu); a[1] *= bf2f(gt.x >> 16); a[2] *= bf2f(gt.y & 0xffffu); a[3] *= bf2f(gt.y >> 16);
                    b[0] *= bf2f(gt.z & 0xffffu); b[1] *= bf2f(gt.z >> 16); b[2] *= bf2f(gt.w & 0xffffu); b[3] *= bf2f(gt.w >> 16);
                    if (!second) { u32x4 w; w.x = cvt_pk_bf16(a[0], a[1]); w.y = cvt_pk_bf16(a[2], a[3]); w.z = cvt_pk_bf16(b[0], b[1]); w.w = cvt_pk_bf16(b[2], b[3]); *(u32x4*)((bf16_t*)tmp + row * 1024 + col) = w; }
                    else {
                        { const u32x4 t = tv[mm][bj]; a[0] += bf2f(t.x & 0xffffu); a[1] += bf2f(t.x >> 16); a[2] += bf2f(t.y & 0xffffu); a[3] += bf2f(t.y >> 16);
                          b[0] += bf2f(t.z & 0xffffu); b[1] += bf2f(t.z >> 16); b[2] += bf2f(t.w & 0xffffu); b[3] += bf2f(t.w >> 16); }
                        u32x4 w; w.x = cvt_pk_bf16(a[0], a[1]); w.y = cvt_pk_bf16(a[2], a[3]); w.z = cvt_pk_bf16(b[0], b[1]); w.w = cvt_pk_bf16(b[2], b[3]);
                        *(u32x4*)(Y + row * 1024 + col) = w;
                    }
                }
        }
    }
};
struct EpiD {
    static constexpr bool PERM = true, AFTER_DRAIN = true;
    const float* x; float* out; const float* fng; float* xb; unsigned* cnt;
    __device__ __forceinline__ void operator()(const f32x4 (&)[2][2][4][2], const pg8::Unit&, int, int, int, int) const {}
    __device__ __forceinline__ void fused(f32x4 (&acc)[2][2][4][2], const pg8::Unit& u, int wr, int wc, int fr, int fq, LAS unsigned char* lds, int wid, int lane) const {
        const int tid = threadIdx.x;
        const int row0 = u.pm * 256 + wr * 64 + fr, col0 = u.pn * 256 + wc * 32 + 8 * fq;
        LAS float* P = (LAS float*)lds;
        LAS float* Sr = (LAS float*)(lds + 4096);
#pragma unroll
        for (int ai = 0; ai < 2; ++ai) {
            f32x4 xa[4][2], xc[4][2];
#pragma unroll
            for (int m = 0; m < 4; ++m)
#pragma unroll
                for (int bj = 0; bj < 2; ++bj) {
                    const size_t off = (size_t)(row0 + ai * 128 + m * 16) * 1024 + col0 + bj * 128;
                    xa[m][bj] = *(const f32x4*)(x + off); xc[m][bj] = *(const f32x4*)(x + off + 4);
                }
#pragma unroll
            for (int m = 0; m < 4; ++m) {
                float ss = 0.f;
#pragma unroll
                for (int bj = 0; bj < 2; ++bj) {
                    const f32x4 a = acc[ai][bj][m][0] + xa[m][bj], b = acc[ai][bj][m][1] + xc[m][bj];
                    acc[ai][bj][m][0] = a; acc[ai][bj][m][1] = b;
                    ss += (a[0] * a[0] + a[1] * a[1]) + (a[2] * a[2] + a[3] * a[3]) + (b[0] * b[0] + b[1] * b[1]) + (b[2] * b[2] + b[3] * b[3]);
                }
                ss += __shfl_xor(ss, 16); ss += __shfl_xor(ss, 32);
                if (fq == 0) P[(ai * 128 + wr * 64 + m * 16 + fr) * 4 + wc] = ss;
            }
        }
        __syncthreads();
        if (tid < 256) {
            const float t = (P[tid * 4] + P[tid * 4 + 1]) + (P[tid * 4 + 2] + P[tid * 4 + 3]);
            __hip_atomic_store(xb + ((size_t)(u.pm * 4 + u.pn)) * 256 + tid, t, __ATOMIC_RELAXED, __HIP_MEMORY_SCOPE_AGENT);
        }
        asm volatile("s_waitcnt vmcnt(0)" ::: "memory");
        __syncthreads();
        if (tid == 0) {
            unsigned* c = cnt + 64 * u.pm;
            (void)__hip_atomic_fetch_add(c, 1u, __ATOMIC_RELAXED, __HIP_MEMORY_SCOPE_AGENT);
            unsigned sp = 0;
            while (__hip_atomic_load(c, __ATOMIC_RELAXED, __HIP_MEMORY_SCOPE_AGENT) < 4u) { __builtin_amdgcn_s_sleep(2); if (++sp > (1u << 22)) break; }
            __builtin_amdgcn_fence(__ATOMIC_ACQUIRE, "agent");
            asm volatile("s_waitcnt vmcnt(0)" ::: "memory");
        }
        __syncthreads();
        if (tid < 256) {
            float t = 0.f;
#pragma unroll
            for (int pn = 0; pn < 4; ++pn) t += __hip_atomic_load(xb + ((size_t)(u.pm * 4 + pn)) * 256 + tid, __ATOMIC_RELAXED, __HIP_MEMORY_SCOPE_AGENT);
            Sr[tid] = __builtin_amdgcn_rsqf(t * (1.f / 1024.f) + RMS_EPS);
        }
        __syncthreads();
#pragma unroll
        for (int bj = 0; bj < 2; ++bj) {
            const f32x4 g0 = *(const f32x4*)(fng + col0 + bj * 128), g1 = *(const f32x4*)(fng + col0 + bj * 128 + 4);
#pragma unroll
            for (int ai = 0; ai < 2; ++ai)
#pragma unroll
                for (int m = 0; m < 4; ++m) {
                    const float rstd = Sr[ai * 128 + wr * 64 + m * 16 + fr];
                    const size_t off = (size_t)(row0 + ai * 128 + m * 16) * 1024 + col0 + bj * 128;
                    *(f32x4*)(out + off) = acc[ai][bj][m][0] * rstd * g0; *(f32x4*)(out + off + 4) = acc[ai][bj][m][1] * rstd * g1;
                }
        }
    }
};

__device__ __forceinline__ void p0_transpose_kn(const float* W, int K, int N, bf16_t* WT, int row_off, LAS float* scr, int kb, int nb, int lane) {
    const int k0 = 64 * kb, n0 = 32 * nb;
    float wv[32];
#pragma unroll
    for (int i = 0; i < 32; ++i) wv[i] = W[(size_t)(k0 + 2 * i + (lane >> 5)) * N + n0 + (lane & 31)];
#pragma unroll
    for (int i = 0; i < 32; ++i) scr[(2 * i + (lane >> 5)) * 33 + (lane & 31)] = wv[i];
    asm volatile("s_waitcnt lgkmcnt(0)" ::: "memory");
    const int c = lane & 7;
#pragma unroll
    for (int j = 0; j < 4; ++j) { const int n = (lane >> 3) + 8 * j; const LAS float* s = scr + (8 * c) * 33 + n;
        u32x4 o; o.x = pk2(s[0 * 33], s[1 * 33]); o.y = pk2(s[2 * 33], s[3 * 33]); o.z = pk2(s[4 * 33], s[5 * 33]); o.w = pk2(s[6 * 33], s[7 * 33]);
        *(u32x4*)(WT + (size_t)(row_off + n0 + n) * K + k0 + 8 * c) = o; }
    asm volatile("s_waitcnt lgkmcnt(0)" ::: "memory");
}

constexpr int SB_KW = 0, SB_VW = 69632, SB_ZS = 137216;
__device__ __forceinline__ void sb_unit(LAS unsigned char* lds, int unit, bf16_t* Q, const bf16_t* Kb, const bf16_t* VT) {
    const int tid = threadIdx.x, lane = tid & 63, w = tid >> 6, r = lane & 15, g = lane >> 4;
    const int bh = unit >> 6, qb = unit & 63, b = bh >> 3, h = bh & 7;
    const size_t rowbase = (size_t)b * SEQ;
    const int tblk = qb * 128, kwin0 = tblk >= 128 ? tblk - 128 : 0;
    LAS bf16_t* Kw = (LAS bf16_t*)(lds + SB_KW);
    LAS bf16_t* Vw = (LAS bf16_t*)(lds + SB_VW);
    LAS float* Zs = (LAS float*)(lds + SB_ZS) + w * (16 * 36);
    {
        u32x4 kv[8], vv[8];
#pragma unroll
        for (int i = 0; i < 8; ++i) { const int c = tid + 512 * i, key = c >> 4, dc = c & 15;
            kv[i] = *(const u32x4*)(Kb + (rowbase + kwin0 + key) * 1024 + h * 128 + 8 * dc); }
#pragma unroll
        for (int i = 0; i < 8; ++i) { const int c = tid + 512 * i, row = c >> 5, kc = c & 31;
            vv[i] = *(const u32x4*)(VT + ((size_t)(bh * 128 + row)) * 8192 + kwin0 + 8 * kc); }
        __syncthreads();
#pragma unroll
        for (int i = 0; i < 8; ++i) { const int c = tid + 512 * i, key = c >> 4, dc = c & 15; *(LAS u32x4*)(Kw + key * 136 + 8 * dc) = kv[i]; }
#pragma unroll
        for (int i = 0; i < 8; ++i) { const int c = tid + 512 * i, row = c >> 5, kc = c & 31; *(LAS u32x4*)(Vw + row * 264 + 8 * kc) = vv[i]; }
    }
    const int t0 = tblk + 16 * w;
    bf16x8 qf[4];
    {
        const bf16_t* qrow = Q + (rowbase + t0 + r) * 1024 + h * 128 + 8 * g;
#pragma unroll
        for (int kk = 0; kk < 4; ++kk) qf[kk] = *(const bf16x8*)(qrow + 32 * kk);
    }
    f32x4 o[8];
#pragma unroll
    for (int n = 0; n < 8; ++n) o[n] = (f32x4){0.f, 0.f, 0.f, 0.f};
    float sacc = 1.f;
    const int t_abs = t0 + r;
    const bf16_t* kbase = Kb + (rowbase + r) * 1024 + h * 128 + 8 * g;
    const bf16_t* vbase = VT + ((size_t)(bh * 128 + r)) * 8192 + 8 * g;
    __syncthreads();
    for (int kt = (t0 + 15) >> 5; kt >= 0; --kt) {
        const int key0 = 32 * kt;
        bf16x8 kf[8], vf[8];
        if (key0 >= kwin0) {
            const LAS bf16_t* kp = Kw + (key0 - kwin0 + r) * 136 + 8 * g;
            const LAS bf16_t* vp = Vw + r * 264 + (key0 - kwin0) + 8 * g;
#pragma unroll
            for (int n = 0; n < 2; ++n)
#pragma unroll
                for (int kk = 0; kk < 4; ++kk) kf[4 * n + kk] = *(const LAS bf16x8*)(kp + (16 * n) * 136 + 32 * kk);
#pragma unroll
            for (int n = 0; n < 8; ++n) vf[n] = *(const LAS bf16x8*)(vp + (16 * n) * 264);
        } else {
#pragma unroll
            for (int n = 0; n < 2; ++n)
#pragma unroll
                for (int kk = 0; kk < 4; ++kk) kf[4 * n + kk] = *(const bf16x8*)(kbase + (size_t)(key0 + 16 * n) * 1024 + 32 * kk);
#pragma unroll
            for (int n = 0; n < 8; ++n) vf[n] = *(const bf16x8*)(vbase + (size_t)(16 * n) * 8192 + key0);
        }
#pragma unroll
        for (int n = 0; n < 2; ++n) {
            f32x4 z = (f32x4){0.f, 0.f, 0.f, 0.f};
#pragma unroll
            for (int kk = 0; kk < 4; ++kk) z = __builtin_amdgcn_mfma_f32_16x16x32_bf16(qf[kk], kf[4 * n + kk], z, 0, 0, 0);
#pragma unroll
            for (int rg = 0; rg < 4; ++rg) Zs[(4 * g + rg) * 36 + 16 * n + r] = z[rg];
        }
        __builtin_amdgcn_wave_barrier();
        bf16x8 afr;
        {
            float zz[8], qs[8], bs[8];
#pragma unroll
            for (int i = 0; i < 2; ++i) { const f32x4 v = *(const LAS f32x4*)(Zs + r * 36 + 8 * g + 4 * i); zz[4 * i] = v[0]; zz[4 * i + 1] = v[1]; zz[4 * i + 2] = v[2]; zz[4 * i + 3] = v[3]; }
            const int j0 = key0 + 8 * g;
            float run = 1.f;
#pragma unroll
            for (int i = 7; i >= 0; --i) {
                const float e = __expf(-fabsf(zz[i])), rr = __builtin_amdgcn_rcpf(1.f + e), er = e * rr;
                const bool pos = zz[i] >= 0.f, valid = (j0 + i) < t_abs;
                bs[i] = valid ? (pos ? rr : er) : 0.f;
                qs[i] = valid ? (pos ? er : rr) : 1.f;
                run *= qs[i];
            }
            const float tot = run;
            const float t1 = __shfl_xor(tot, 16), t2 = __shfl_xor(tot, 32), t3 = __shfl_xor(t1, 32);
            const float after = (g == 0) ? (t1 * t2 * t3) : (g == 1) ? (t2 * t3) : (g == 2) ? t1 : 1.f;
            float psuf = after * sacc;
            unsigned pw[4];
#pragma unroll
            for (int i = 3; i >= 0; --i) {
                const float w1 = bs[2 * i + 1] * psuf; psuf *= qs[2 * i + 1];
                const float w0 = bs[2 * i] * psuf; psuf *= qs[2 * i];
                pw[i] = cvt_pk_bf16(w0, w1);
            }
            afr = __builtin_bit_cast(bf16x8, ((u32x4){pw[0], pw[1], pw[2], pw[3]}));
            sacc *= (tot * t1) * (t2 * t3);
        }
        __builtin_amdgcn_wave_barrier();
#pragma unroll
        for (int n = 0; n < 8; ++n) o[n] = __builtin_amdgcn_mfma_f32_16x16x32_bf16(afr, vf[n], o[n], 0, 0, 0);
        float mx = sacc;
#pragma unroll
        for (int s = 1; s < 16; s <<= 1) mx = fmaxf(mx, __shfl_xor(mx, s));
        if (mx == 0.f) break;
    }
#pragma unroll
    for (int n = 0; n < 8; ++n)
#pragma unroll
        for (int rg = 0; rg < 4; ++rg)
            Q[(rowbase + t0 + 4 * g + rg) * 1024 + h * 128 + 16 * n + r] = (bf16_t)f2bf(o[n][rg]);
}

__device__ __forceinline__ void grp_arrive(unsigned* c) {
    asm volatile("s_waitcnt vmcnt(0)" ::: "memory");
    __syncthreads();
    if (threadIdx.x == 0) (void)__hip_atomic_fetch_add(c, 1u, __ATOMIC_RELAXED, __HIP_MEMORY_SCOPE_AGENT);
}
__device__ __forceinline__ void grp_wait(unsigned* c, unsigned target) {
    if (threadIdx.x == 0) {
        unsigned sp = 0;
        while (__hip_atomic_load(c, __ATOMIC_RELAXED, __HIP_MEMORY_SCOPE_AGENT) < target) { __builtin_amdgcn_s_sleep(2); if (++sp > (1u << 22)) break; }
        __builtin_amdgcn_fence(__ATOMIC_ACQUIRE, "agent");
        asm volatile("s_waitcnt vmcnt(0)" ::: "memory");
    }
    __syncthreads();
}

constexpr int HG_QT = 0, HG_KT = 17408, HG_KD = 34816, HG_VT = 53248, HG_AS = 71680, HG_SP = 80896, HG_PT = 115712, HG_DL = 117760, HG_DM = 118272;
struct HgRegs { float gv[16]; unsigned vv[16]; unsigned qv[16]; };
template <bool FULL>
__device__ __forceinline__ void hg_load(HgRegs& R, size_t m0, int h, const float* G, const bf16_t* HQ, const bf16_t* HI) {
    const int tid = threadIdx.x, k = tid & 127, part = tid >> 7;
    const size_t base = (m0 + 16 * part) * 1024 + h * 128 + k;
#pragma unroll
    for (int i = 0; i < 16; ++i) R.gv[i] = bf2f(((const bf16_t*)G)[base + (size_t)i * 1024]);
#pragma unroll
    for (int i = 0; i < 16; ++i) R.vv[i] = HI[base + (size_t)i * 1024];
    if (FULL) {
#pragma unroll
        for (int i = 0; i < 16; ++i) R.qv[i] = HQ[base + (size_t)i * 1024];
    }
}
template <bool FULL>
__device__ __forceinline__ float hg_prep(LAS unsigned char* lds, const HgRegs& R) {
    const int tid = threadIdx.x, k = tid & 127, part = tid >> 7;
    LAS float* ptot = (LAS float*)(lds + HG_PT);
    float gv[16], cs[16];
    float run = 0.f;
#pragma unroll
    for (int i = 0; i < 16; ++i) { gv[i] = R.gv[i]; run += gv[i]; cs[i] = run; }
    ptot[part * 128 + k] = run;
    unsigned vv[16];
#pragma unroll
    for (int i = 0; i < 16; ++i) vv[i] = R.vv[i];
    __syncthreads();
    const float p0 = ptot[k], p1 = ptot[128 + k], p2 = ptot[256 + k], p3 = ptot[384 + k];
    const float off = (part == 0) ? 0.f : (part == 1) ? p0 : (part == 2) ? (p0 + p1) : (p0 + p1 + p2);
    const float last = (p0 + p1) + (p2 + p3), mid = p0 + p1;
    LAS bf16_t* kdT = (LAS bf16_t*)(lds + HG_KD);
    LAS bf16_t* vT = (LAS bf16_t*)(lds + HG_VT);
    unsigned pk[8];
    float kkv[16], em[16];
    const float clm = __expf(last - mid);
#pragma unroll
    for (int i = 0; i < 16; ++i) { kkv[i] = 1.f - __expf(gv[i]); em[i] = __expf((FULL ? mid : last) - (cs[i] + off)); }
#pragma unroll
    for (int i = 0; i < 8; ++i) {
        const float a = kkv[2 * i] * em[2 * i] * (FULL ? clm : 1.f), c = kkv[2 * i + 1] * em[2 * i + 1] * (FULL ? clm : 1.f);
        pk[i] = cvt_pk_bf16(a, c);
    }
    *(LAS u32x4*)(kdT + k * 72 + 16 * part) = (u32x4){pk[0], pk[1], pk[2], pk[3]};
    *(LAS u32x4*)(kdT + k * 72 + 16 * part + 8) = (u32x4){pk[4], pk[5], pk[6], pk[7]};
    *(LAS u32x4*)(vT + k * 72 + 16 * part) = (u32x4){vv[0] | (vv[1] << 16), vv[2] | (vv[3] << 16), vv[4] | (vv[5] << 16), vv[6] | (vv[7] << 16)};
    *(LAS u32x4*)(vT + k * 72 + 16 * part + 8) = (u32x4){vv[8] | (vv[9] << 16), vv[10] | (vv[11] << 16), vv[12] | (vv[13] << 16), vv[14] | (vv[15] << 16)};
    if (FULL) {
        LAS bf16_t* qt = (LAS bf16_t*)(lds + HG_QT);
        LAS bf16_t* kt = (LAS bf16_t*)(lds + HG_KT);
#pragma unroll
        for (int i = 0; i < 16; ++i) {
            const float q = bf2f(R.qv[i]);
            qt[(16 * part + i) * 136 + k] = (bf16_t)f2bf(q * __builtin_amdgcn_rcpf(em[i]));
            kt[(16 * part + i) * 136 + k] = (bf16_t)f2bf(kkv[i] * em[i]);
        }
    }
    if (part == 0) { ((LAS float*)(lds + HG_DL))[k] = __expf(last); if (FULL) ((LAS float*)(lds + HG_DM))[k] = __expf(mid); }
    return last;
}
__device__ __forceinline__ void hg_state_update(LAS unsigned char* lds, f32x4 (&S)[8], int w, int r, int g) {
    const LAS bf16_t* kdT = (const LAS bf16_t*)(lds + HG_KD);
    const LAS bf16_t* vT = (const LAS bf16_t*)(lds + HG_VT);
    const LAS float* dl = (const LAS float*)(lds + HG_DL);
    const bf16x8 b0 = *(const LAS bf16x8*)(vT + (16 * w + r) * 72 + 8 * g), b1 = *(const LAS bf16x8*)(vT + (16 * w + r) * 72 + 32 + 8 * g);
#pragma unroll
    for (int i = 0; i < 8; ++i) {
        const f32x4 d = *(const LAS f32x4*)(dl + 16 * i + 4 * g);
        S[i] = S[i] * d;
        const bf16x8 a0 = *(const LAS bf16x8*)(kdT + (16 * i + r) * 72 + 8 * g), a1 = *(const LAS bf16x8*)(kdT + (16 * i + r) * 72 + 32 + 8 * g);
        S[i] = __builtin_amdgcn_mfma_f32_16x16x32_bf16(a0, b0, S[i], 0, 0, 0);
        S[i] = __builtin_amdgcn_mfma_f32_16x16x32_bf16(a1, b1, S[i], 0, 0, 0);
    }
}
__device__ __forceinline__ void hg_unit_a(LAS unsigned char* lds, int unit, const float* G, const bf16_t* HI, float* ST, float* DG, unsigned* cnt) {
    const int tid = threadIdx.x, lane = tid & 63, w = tid >> 6, r = lane & 15, g = lane >> 4;
    const int bh = unit >> 5, c = unit & 31, b = bh >> 3, h = bh & 7;
    f32x4 S[8];
#pragma unroll
    for (int i = 0; i < 8; ++i) S[i] = (f32x4){0.f, 0.f, 0.f, 0.f};
    float cumtot = 0.f;
    HgRegs R;
    const size_t mu = (size_t)b * SEQ + c * 256;
    hg_load<false>(R, mu, h, G, nullptr, HI);
    for (int sc = 0; sc < 4; ++sc) {
        __syncthreads();
        cumtot += hg_prep<false>(lds, R);
        if (sc < 3) hg_load<false>(R, mu + (sc + 1) * 64, h, G, nullptr, HI);
        __syncthreads();
        hg_state_update(lds, S, w, r, g);
    }
    float* U = ST + (size_t)unit * 16384;
#pragma unroll
    for (int i = 0; i < 8; ++i)
#pragma unroll
        for (int rg = 0; rg < 4; ++rg) __hip_atomic_store(&U[(16 * i + 4 * g + rg) * 128 + 16 * w + r], S[i][rg], __ATOMIC_RELAXED, __HIP_MEMORY_SCOPE_AGENT);
    if (tid < 128) __hip_atomic_store(&DG[unit * 128 + tid], __expf(cumtot), __ATOMIC_RELAXED, __HIP_MEMORY_SCOPE_AGENT);
    if (cnt) grp_arrive(cnt + 64 * bh);
}
__device__ __forceinline__ void hg_unit_c(LAS unsigned char* lds, int unit, const float* G, bf16_t* HQ, const bf16_t* HI, const float* ST, const float* ng) {
    const int tid = threadIdx.x, lane = tid & 63, w = tid >> 6, r = lane & 15, g = lane >> 4;
    const int bh = unit >> 5, c = unit & 31, b = bh >> 3, h = bh & 7;
    f32x4 S[8];
    {
        const float* U = ST + (size_t)unit * 16384;
#pragma unroll
        for (int i = 0; i < 8; ++i)
#pragma unroll
            for (int rg = 0; rg < 4; ++rg) S[i][rg] = U[(16 * i + 4 * g + rg) * 128 + 16 * w + r];
    }
    LAS bf16_t* qt = (LAS bf16_t*)(lds + HG_QT);
    LAS bf16_t* kt = (LAS bf16_t*)(lds + HG_KT);
    LAS bf16_t* vT = (LAS bf16_t*)(lds + HG_VT);
    LAS bf16_t* As = (LAS bf16_t*)(lds + HG_AS);
    LAS bf16_t* SpT = (LAS bf16_t*)(lds + HG_SP) + w * (16 * 136);
    LAS float* Os = (LAS float*)(lds + HG_QT);
    const LAS float* dm = (const LAS float*)(lds + HG_DM);
    HgRegs R;
    hg_load<true>(R, (size_t)b * SEQ + c * 256, h, G, HQ, HI);
    for (int sc = 0; sc < 4; ++sc) {
        const size_t m0 = (size_t)b * SEQ + c * 256 + sc * 64;
        __syncthreads();
        (void)hg_prep<true>(lds, R);
        if (sc < 3) hg_load<true>(R, m0 + 64, h, G, HQ, HI);
        __syncthreads();
#pragma unroll
        for (int i = 0; i < 8; ++i) {
            const f32x4 d = *(const LAS f32x4*)(dm + 16 * i + 4 * g);
            const f32x4 s = S[i] * d;
            *(LAS u32x2*)(SpT + r * 136 + 16 * i + 4 * g) = (u32x2){cvt_pk_bf16(s[0], s[1]), cvt_pk_bf16(s[2], s[3])};
        }
#pragma unroll
        for (int tt = 0; tt < 2; ++tt) {
            const int tile = 2 * w + tt, ti = tile >> 2, si = tile & 3;
            f32x4 a = (f32x4){0.f, 0.f, 0.f, 0.f};
            if (si <= ti) {
#pragma unroll
                for (int kk = 0; kk < 4; ++kk) {
                    const bf16x8 af = *(const LAS bf16x8*)(qt + (16 * ti + r) * 136 + 32 * kk + 8 * g);
                    const bf16x8 bf = *(const LAS bf16x8*)(kt + (16 * si + r) * 136 + 32 * kk + 8 * g);
                    a = __builtin_amdgcn_mfma_f32_16x16x32_bf16(af, bf, a, 0, 0, 0);
                }
            }
#pragma unroll
            for (int rg = 0; rg < 4; ++rg) {
                const int t = 16 * ti + 4 * g + rg, s = 16 * si + r;
                As[t * 72 + s] = (bf16_t)f2bf((s <= t) ? a[rg] : 0.f);
            }
        }
        __syncthreads();
        f32x4 o[4];
        {
            const bf16x8 vb0 = *(const LAS bf16x8*)(vT + (16 * w + r) * 72 + 8 * g), vb1 = *(const LAS bf16x8*)(vT + (16 * w + r) * 72 + 32 + 8 * g);
            bf16x8 sb[4];
#pragma unroll
            for (int kk = 0; kk < 4; ++kk) sb[kk] = *(const LAS bf16x8*)(SpT + r * 136 + 32 * kk + 8 * g);
#pragma unroll
            for (int ti = 0; ti < 4; ++ti) {
                f32x4 a = (f32x4){0.f, 0.f, 0.f, 0.f};
                const bf16x8 a0 = *(const LAS bf16x8*)(As + (16 * ti + r) * 72 + 8 * g), a1 = *(const LAS bf16x8*)(As + (16 * ti + r) * 72 + 32 + 8 * g);
                a = __builtin_amdgcn_mfma_f32_16x16x32_bf16(a0, vb0, a, 0, 0, 0);
                a = __builtin_amdgcn_mfma_f32_16x16x32_bf16(a1, vb1, a, 0, 0, 0);
#pragma unroll
                for (int kk = 0; kk < 4; ++kk) {
                    const bf16x8 qf = *(const LAS bf16x8*)(qt + (16 * ti + r) * 136 + 32 * kk + 8 * g);
                    a = __builtin_amdgcn_mfma_f32_16x16x32_bf16(qf, sb[kk], a, 0, 0, 0);
                }
                o[ti] = a;
            }
        }
        hg_state_update(lds, S, w, r, g);
        __syncthreads();
#pragma unroll
        for (int ti = 0; ti < 4; ++ti)
#pragma unroll
            for (int rg = 0; rg < 4; ++rg) Os[(16 * ti + 4 * g + rg) * 132 + 16 * w + r] = o[ti][rg];
        __syncthreads();
        {
            const int t = tid >> 3, sg = tid & 7;
            f32x4 v[4]; float ss = 0.f;
#pragma unroll
            for (int i = 0; i < 4; ++i) { v[i] = *(const LAS f32x4*)(Os + t * 132 + 16 * sg + 4 * i); ss += (v[i][0] * v[i][0] + v[i][1] * v[i][1]) + (v[i][2] * v[i][2] + v[i][3] * v[i][3]); }
            ss += __shfl_xor(ss, 1); ss += __shfl_xor(ss, 2); ss += __shfl_xor(ss, 4);
            const float rstd = __builtin_amdgcn_rsqf(ss * (1.f / 128.f) + RMS_EPS);
            const float* gp = ng + h * 128 + 16 * sg;
            unsigned pk[8];
#pragma unroll
            for (int i = 0; i < 4; ++i) {
                const f32x4 gg = *(const f32x4*)(gp + 4 * i);
                pk[2 * i] = cvt_pk_bf16(v[i][0] * rstd * gg[0], v[i][1] * rstd * gg[1]);
                pk[2 * i + 1] = cvt_pk_bf16(v[i][2] * rstd * gg[2], v[i][3] * rstd * gg[3]);
            }
            bf16_t* op = HQ + (m0 + t) * 1024 + h * 128 + 16 * sg;
            *(u32x4*)op = (u32x4){pk[0], pk[1], pk[2], pk[3]};
            *(u32x4*)(op + 8) = (u32x4){pk[4], pk[5], pk[6], pk[7]};
        }
    }
}

#define XB_TMO      128
#define XB_XCNT(j)  (256  + 64 * (j))
#define XB_XSUB(j)  (1280 + 64 * (j))
#define XB_XGEN(j)  (2304 + 64 * (j))
#define XB_TOP      3328
#define XB_TOPGEN   3392
#define XCD_BAR_WORDS 3456
#define XB_SPIN_CAP (1u << 18)
__device__ __forceinline__ unsigned xb_ld(unsigned* p)              { return __hip_atomic_load(p, __ATOMIC_RELAXED, __HIP_MEMORY_SCOPE_AGENT); }
__device__ __forceinline__ unsigned xb_add(unsigned* p, unsigned v) { return __hip_atomic_fetch_add(p, v, __ATOMIC_RELAXED, __HIP_MEMORY_SCOPE_AGENT); }
__device__ __forceinline__ unsigned xb_xcc_id() { return (unsigned)__builtin_amdgcn_s_getreg((3 << 11) | 20) & 0xFu; }
#define XB_SPIN(cond, bar) do { unsigned _sp = 0; while (cond) { __builtin_amdgcn_s_sleep(1); \
    if ((++_sp & 255u) == 0u) { if (xb_ld(&(bar)[XB_TMO])) break; if (_sp > XB_SPIN_CAP) { atomicAdd(&(bar)[XB_TMO], 1u); break; } } } } while (0)
struct XcdBarrier { unsigned* bar; unsigned x; volatile LAS unsigned* st; };
__device__ __forceinline__ XcdBarrier xcd_barrier_post(unsigned* bar, volatile LAS unsigned* st) {
    XcdBarrier b; b.bar = bar; b.x = xb_xcc_id(); b.st = st;
    if (threadIdx.x == 0) (void)xb_add(&bar[XB_XCNT(b.x)], 1u);
    return b;
}
__device__ __forceinline__ void xcd_barrier_complete(unsigned* bar, unsigned x, unsigned& nloc, unsigned& nx) {
    const unsigned G = gridDim.x * gridDim.y * gridDim.z;
    unsigned sum, cnt, mine, sp = 0u;
    for (;;) {
        sum = 0u; cnt = 0u; mine = 0u;
#pragma unroll
        for (unsigned j = 0; j < 16; ++j) { const unsigned c = xb_ld(&bar[XB_XCNT(j)]); sum += c; cnt += (c > 0u) ? 1u : 0u; mine = (j == x) ? c : mine; }
        if (sum == G) break;
        __builtin_amdgcn_s_sleep(1);
        if ((++sp & 255u) == 0u) { if (xb_ld(&bar[XB_TMO])) break; if (sp > XB_SPIN_CAP) { atomicAdd(&bar[XB_TMO], 1u); break; } }
    }
    nloc = mine > 0u ? mine : 1u; nx = cnt > 0u ? cnt : 1u;
}
__device__ __forceinline__ void xcd_barrier(const XcdBarrier& b) {
    asm volatile("s_waitcnt vmcnt(0)" ::: "memory");
    __syncthreads();
    if (threadIdx.x == 0) {
        unsigned* bar = b.bar;
        __builtin_amdgcn_s_waitcnt(0);
        unsigned nloc = b.st[0], nx = b.st[1];
        if (nloc == 0u) { xcd_barrier_complete(bar, b.x, nloc, nx); b.st[0] = nloc; b.st[1] = nx; }
        const unsigned old = xb_add(&bar[XB_XSUB(b.x)], 1u);
        const unsigned gen = old / nloc;
        if (old + 1u == (gen + 1u) * nloc) {
            __builtin_amdgcn_fence(__ATOMIC_RELEASE, "agent");
            asm volatile("s_waitcnt vmcnt(0)" ::: "memory");
            const unsigned og = xb_add(&bar[XB_TOP], 1u);
            const unsigned tg = og / nx;
            if (og + 1u == (tg + 1u) * nx) xb_add(&bar[XB_TOPGEN], 1u);
            else XB_SPIN(xb_ld(&bar[XB_TOPGEN]) == tg, bar);
            __builtin_amdgcn_fence(__ATOMIC_ACQUIRE, "agent");
            xb_add(&bar[XB_XGEN(b.x)], 1u);
            asm volatile("s_waitcnt vmcnt(0)" ::: "memory");
        } else {
            XB_SPIN(xb_ld(&bar[XB_XGEN(b.x)]) == gen, bar);
            __builtin_amdgcn_fence(__ATOMIC_ACQUIRE, "agent");
            asm volatile("s_waitcnt vmcnt(0)" ::: "memory");
        }
    }
    __syncthreads();
}

struct Args { const float* in[10]; float* out; unsigned char* ws; int ph_lo, ph_hi; };
__global__ void __launch_bounds__(512, 2) mk_fwd(Args args) {
    extern __shared__ __attribute__((aligned(16))) unsigned char lds_raw[];
    LAS unsigned char* lds = (LAS unsigned char*)lds_raw;
    cg::grid_group grid = cg::this_grid();
    const int tid = threadIdx.x, lane = tid & 63, wave = tid >> 6;
    const int G = gridDim.x, bid = blockIdx.x;
    unsigned char* ws = args.ws;
    const float* x = args.in[0]; const float* norm_g = args.in[1]; const float* w_in = args.in[2]; const float* b_gate = args.in[3];
    const float* lb_logits = args.in[4]; const float* hg_norm_g = args.in[5]; const float* w_sb = args.in[6]; const float* w_hg = args.in[7];
    const float* w_out = args.in[8]; const float* fng = args.in[9];
    float* out = args.out;
    bf16_t* Wt_in = (bf16_t*)(ws + WS_WIN); bf16_t* Wt_sbhg = (bf16_t*)(ws + WS_WSBHG); bf16_t* Wt_out = (bf16_t*)(ws + WS_WOUT);
    float* DG = (float*)(ws + WS_HGD);
    bf16_t* Hn = (bf16_t*)(ws + WS_H); bf16_t* SBQ = (bf16_t*)(ws + WS_SBQ); bf16_t* HGQ = (bf16_t*)(ws + WS_HGQ);
    bf16_t* SBK = (bf16_t*)(ws + WS_SBK); bf16_t* SBV = (bf16_t*)(ws + WS_SBV); bf16_t* HGI = (bf16_t*)(ws + WS_HGI);
    float* ST = (float*)(ws + WS_ST); bf16_t* GATES = (bf16_t*)(ws + WS_GATES); bf16_t* Y = (bf16_t*)(ws + WS_Y);
    float* Gf = out;
    const int lo = args.ph_lo, hi = args.ph_hi;
    if (lo < 0) grid.sync();
    if (tid < 16) ((LAS unsigned*)(lds + LDS_MISC))[tid] = 0u;
    __syncthreads();
    XcdBarrier bar = xcd_barrier_post((unsigned*)ws, (volatile LAS unsigned*)(lds + LDS_MISC));
#define IN(k) (lo <= (k) && (k) < hi)
#define SEAM(k) do { if (IN(k) && IN((k) + 1)) xcd_barrier(bar); } while (0)

    if (IN(0)) {
        LAS float* scr = (LAS float*)(lds + wave * 16384);
        const int gw = bid * 8 + wave, NGW = G * 8;
        for (int it = gw; it < 16 * 192; it += NGW) {
            const int kb = it / 192, j = it % 192, sg = j >> 5, seg = sg < 3 ? sg : sg + 1;
            p0_transpose_kn(w_in, 1024, 10240, Wt_in, 0, scr, kb, seg * 32 + (j & 31), lane);
        }
        for (int m4 = gw * 4; m4 < M_TOK; m4 += NGW * 4) {
            f32x4 v[4][4]; float s2[4];
#pragma unroll
            for (int q = 0; q < 4; ++q) { const f32x4* xr = (const f32x4*)(x + (size_t)(m4 + q) * 1024) + lane;
#pragma unroll
                for (int j = 0; j < 4; ++j) v[q][j] = xr[64 * j]; }
#pragma unroll
            for (int q = 0; q < 4; ++q) { s2[q] = 0.f;
#pragma unroll
                for (int j = 0; j < 4; ++j) s2[q] += (v[q][j][0] * v[q][j][0] + v[q][j][1] * v[q][j][1]) + (v[q][j][2] * v[q][j][2] + v[q][j][3] * v[q][j][3]); }
#pragma unroll
            for (int o = 1; o < 64; o <<= 1) {
#pragma unroll
                for (int q = 0; q < 4; ++q) s2[q] += __shfl_xor(s2[q], o); }
#pragma unroll
            for (int q = 0; q < 4; ++q) {
                const float rstd = __builtin_amdgcn_rsqf(s2[q] * (1.f / 1024.f) + RMS_EPS);
                u32x2* o8 = (u32x2*)(Hn + (size_t)(m4 + q) * 1024) + lane;
#pragma unroll
                for (int j = 0; j < 4; ++j) { const f32x4 gg = *((const f32x4*)norm_g + lane + 64 * j);
                    o8[64 * j] = (u32x2){pk2(v[q][j][0] * rstd * gg[0], v[q][j][1] * rstd * gg[1]), pk2(v[q][j][2] * rstd * gg[2], v[q][j][3] * rstd * gg[3])}; }
            }
        }
        __syncthreads();
    }
    SEAM(0);
    if (IN(1)) {
        pg8::Gemm g{Hn, Wt_in, M_TOK, 10240, 1024}; pg8::SegOrder S; S.init(G, bid, 0);
        EpiA E{SBQ, SBK, SBV, HGQ, HGI, Gf, lb_logits};
        pg8::gemm_phase<EpiA, pg8::SegOrder, true, true>(lds, g, S, E);
    }
    SEAM(1);
    const bool scan_in_p2 = (G == 256);
    unsigned* cntA = (unsigned*)(ws + 65536);
    unsigned* cntS = (unsigned*)(ws + 65536 + 4096);
    if (IN(2)) {
        for (int u = bid; u < 512; u += G) hg_unit_a(lds, u, Gf, HGI, ST, DG, scan_in_p2 ? cntA : nullptr);
        __syncthreads();
        for (int u = bid; u < 1024; u += G) sb_unit(lds, u, SBQ, SBK, SBV);
        __syncthreads();
        if (scan_in_p2) {
            grp_wait(cntA + 64 * (bid >> 5), 32u); grp_wait(cntA + 64 * ((bid >> 5) + 8), 32u);
#pragma unroll
            for (int j = 0; j < 2; ++j) {
                const int bh = (bid >> 5) + 8 * j;
                const int kv = (bid & 31) * 512 + tid, k = kv >> 7;
                float* stp = ST + ((size_t)(bh * 32) << 14) + kv;
                const float* dgp = DG + (bh * 32) * 128 + k;
                float u[32], d[32];
#pragma unroll
                for (int c = 0; c < 32; ++c) { u[c] = stp[(size_t)c << 14]; d[c] = dgp[c * 128]; }
                float S = 0.f;
#pragma unroll
                for (int c = 0; c < 32; ++c) { __hip_atomic_store(&stp[(size_t)c << 14], S, __ATOMIC_RELAXED, __HIP_MEMORY_SCOPE_AGENT); S = d[c] * S + u[c]; }
            }
            grp_arrive(cntS + 64 * (bid >> 5));
        }
    }
    if (!scan_in_p2) SEAM(2);
    if (IN(3) && !scan_in_p2) {
        for (int e = bid * 512 + tid; e < 16 * 16384; e += G * 512) {
            const int bh = e >> 14, kv = e & 16383, k = kv >> 7;
            float* stp = ST + ((size_t)(bh * 32) << 14) + kv;
            const float* dgp = DG + (bh * 32) * 128 + k;
            float u[32], d[32];
#pragma unroll
            for (int c = 0; c < 32; ++c) { u[c] = stp[(size_t)c << 14]; d[c] = dgp[c * 128]; }
            float S = 0.f;
#pragma unroll
            for (int c = 0; c < 32; ++c) { stp[(size_t)c << 14] = S; S = d[c] * S + u[c]; }
        }
    }
    if (IN(3) && IN(4) && !scan_in_p2) xcd_barrier(bar);
    if (IN(4)) {
        {
            LAS float* scr = (LAS float*)(lds + wave * 16384);
            const int gw = bid * 8 + wave, NGW = G * 8;
            for (int it = gw; it < 16 * 128 + 3 * 512; it += NGW) {
                int r = it;
                if (r < 16 * 128) { const int kb = r / 128, j = r % 128, sg = j >> 5, seg = sg == 0 ? 3 : sg + 6; p0_transpose_kn(w_in, 1024, 10240, Wt_in, 0, scr, kb, seg * 32 + (j & 31), lane); continue; } r -= 16 * 128;
                if (r < 512) { p0_transpose_kn(w_sb, 1024, 1024, Wt_sbhg, 0, scr, r / 32, r % 32, lane); continue; } r -= 512;
                if (r < 512) { p0_transpose_kn(w_hg, 1024, 1024, Wt_sbhg, 1024, scr, r / 32, r % 32, lane); continue; } r -= 512;
                p0_transpose_kn(w_out, 1024, 1024, Wt_out, 0, scr, r / 32, r % 32, lane);
            }
            __syncthreads();
        }
        if (scan_in_p2) grp_wait(cntS + 64 * (bid >> 5), 32u);
        for (int u = bid; u < 512; u += G) hg_unit_c(lds, u, Gf, HGQ, HGI, ST, hg_norm_g);
        __syncthreads();
    }
    SEAM(4);
    if (IN(5)) {
        pg8::Gemm g{Hn, Wt_in, M_TOK, 10240, 1024}; pg8::SegOrder S; S.init(G, bid, 1);
        EpiB E{SBQ, HGQ, GATES, b_gate};
        pg8::gemm_phase<EpiB, pg8::SegOrder, true, true>(lds, g, S, E);
    }
    SEAM(5);
    if (IN(6)) {
        pg8::Gemm g{SBQ, Wt_sbhg, 2 * M_TOK, 2048, 1024}; pg8::PairOrder S; S.init(G, bid);
        EpiC E{GATES, out, Y};
        pg8::gemm_phase<EpiC, pg8::PairOrder, true, true>(lds, g, S, E);
    }
    SEAM(6);
    if (IN(7)) {
        pg8::Gemm g{Y, Wt_out, M_TOK, 1024, 1024}; pg8::PlainOrder S; S.init(M_TOK, 1024, G, bid);
        EpiD E{x, out, fng, (float*)(ws + 131072), (unsigned*)(ws + 16384)};
        pg8::gemm_phase<EpiD, pg8::PlainOrder, true, true>(lds, g, S, E);
    }
#undef IN
#undef SEAM
}

#ifndef MK_N_LAUNCHES
#define MK_N_LAUNCHES 1
#endif
extern "C" void kernel_launch(void* const* d_in, const int* in_sizes, int n_in, void* d_out, int out_size, void* d_ws, size_t ws_size, hipStream_t stream) {
    static int grid = 0;
    if (grid == 0) {
        if (n_in != 10 || out_size != M_TOK * DM || ws_size < WS_END) { fprintf(stderr, "kernel_launch: unexpected shapes (n_in %d out %d ws %zu)\n", n_in, out_size, ws_size); grid = -1; return; }
        int dev = 0, cus = 0, per_cu = 0;
        (void)hipGetDevice(&dev);
        (void)hipDeviceGetAttribute(&cus, hipDeviceAttributeMultiprocessorCount, dev);
        if (hipFuncSetAttribute((const void*)mk_fwd, hipFuncAttributeMaxDynamicSharedMemorySize, LDS_BYTES) != hipSuccess) { fprintf(stderr, "kernel_launch: hipFuncSetAttribute failed\n"); grid = -1; return; }
        if (hipOccupancyMaxActiveBlocksPerMultiprocessor(&per_cu, (const void*)mk_fwd, 512, LDS_BYTES) != hipSuccess || per_cu < 1) { fprintf(stderr, "kernel_launch: occupancy query says %d\n", per_cu); per_cu = 1; }
        (void)hipGetLastError();
        grid = cus > 0 ? cus : 256;
    }
    if (grid < 0) return;
    if (hipMemsetAsync(d_ws, 0, 65536 + 8192, stream) != hipSuccess) { fprintf(stderr, "kernel_launch: memset failed\n"); return; }
    Args a{};
    for (int i = 0; i < 10; ++i) a.in[i] = (const float*)d_in[i];
    a.out = (float*)d_out; a.ws = (unsigned char*)d_ws;
#if MK_N_LAUNCHES == 1
    a.ph_lo = 0; a.ph_hi = 8;
    void* kargs[] = {&a};
    hipError_t e = hipLaunchCooperativeKernel((const void*)mk_fwd, dim3(grid), dim3(512), kargs, LDS_BYTES, stream);
    if (e != hipSuccess) fprintf(stderr, "kernel_launch: cooperative launch failed: %s (grid %d)\n", hipGetErrorString(e), grid);
#else
    for (int p = 0; p < 8; ++p) { a.ph_lo = p; a.ph_hi = p + 1; hipLaunchKernelGGL(mk_fwd, dim3(grid), dim3(512), LDS_BYTES, stream, a); }
#endif
}
```

```cpp
#include <hip/hip_runtime.h>
#include <hip/hip_cooperative_groups.h>
#include <cstdio>
#include <cstdint>
namespace cg = cooperative_groups;

#define LAS __attribute__((address_space(3)))
typedef unsigned short bf16_t;
typedef short bf16x8 __attribute__((ext_vector_type(8)));
typedef float f32x4 __attribute__((ext_vector_type(4)));
typedef unsigned u32x4 __attribute__((ext_vector_type(4)));
typedef unsigned u32x2 __attribute__((ext_vector_type(2)));

namespace pg8 {
constexpr int BM = 256, BK = 64, HALF = 128, HTB = HALF * BK * 2, STAGE_BYTES = 8 * HTB, NXCD = 8, WGM = 8;
__host__ __device__ __forceinline__ int lds_byte(int r, int c) { const int st = (r >> 4) * 2 + (c >> 5), rr = r & 15, cc = c & 31, ob = rr * 64 + cc * 2; return st * 1024 + (ob ^ (((ob >> 9) & 1) << 5)); }
__host__ __device__ __forceinline__ void stage_rc(int b, int& R, int& C) { const int st = b / 1024, sb = b % 1024, swz = sb ^ (((sb >> 9) & 1) << 5); R = (st >> 1) * 16 + swz / 64; C = (st & 1) * 32 + (swz % 64) / 2; }
__host__ __device__ __forceinline__ int perm32(int rho) { const int n = rho >> 4, i = rho & 15; return 8 * (i >> 2) + 4 * n + (i & 3); }

struct Unit { int pm, pn; };
struct Gemm { const bf16_t* A; const bf16_t* Bt; int M, N, K; };

struct StaticOrder {
    int nM, nN, nwg, G, c;
    __host__ __device__ void init(int M, int N, int G_, int c_) { nM = M / BM; nN = N / BM; nwg = nM * nN; G = G_; c = c_; }
    __host__ __device__ bool next(int i, Unit& u) const {
        const long L = (long)i * G + c; if (L >= nwg) return false;
        int wgid = (int)L; { const int q = nwg / NXCD, r = nwg % NXCD, xcd = wgid % NXCD, off = wgid / NXCD; wgid = (xcd < r ? xcd * (q + 1) : r * (q + 1) + (xcd - r) * q) + off; }
        const int nig = WGM * nN, gid = wgid / nig, fm = gid * WGM, gsz = (nM - fm) < WGM ? (nM - fm) : WGM;
        u.pm = fm + ((wgid % nig) % gsz); u.pn = (wgid % nig) / gsz; return true;
    }
};
struct SegOrder {
    StaticOrder so; int mode;
    __device__ void init(int G, int c, int mode_) { mode = mode_; so.init(16384, (mode_ == 0 ? 24 : 16) * 256, G, c); }
    __device__ bool next(int i, Unit& u) const {
        if (!so.next(i, u)) return false;
        if (mode == 0) u.pn = (u.pn < 12) ? u.pn : u.pn + 4; else u.pn = (u.pn < 4) ? u.pn + 12 : u.pn + 24;
        return true;
    }
    __device__ __forceinline__ void a_ready(const Unit&) const {}
    __device__ __forceinline__ void done(const Unit&) const {}
};
struct PairOrder {
    StaticOrder so;
    __device__ void init(int G, int c) { so.init(16384, 1024, G, c); }
    __device__ bool next(int i, Unit& u) const { if (!so.next(i >> 1, u)) return false; u.pm += 64 * (i & 1); u.pn += 4 * (i & 1); return true; }
    __device__ __forceinline__ void a_ready(const Unit&) const {}
    __device__ __forceinline__ void done(const Unit&) const {}
};
struct PlainOrder {
    StaticOrder so;
    __device__ void init(int M, int N, int G, int c) { so.init(M, N, G, c); }
    __device__ bool next(int i, Unit& u) const { return so.next(i, u); }
    __device__ __forceinline__ void a_ready(const Unit&) const {}
    __device__ __forceinline__ void done(const Unit&) const {}
};

typedef float f32x2_t __attribute__((ext_vector_type(2)));
typedef __bf16 bf16x2_t __attribute__((ext_vector_type(2)));
__device__ __forceinline__ unsigned cvt_pk_bf16(float lo, float hi) { f32x2_t v = {lo, hi}; bf16x2_t b = __builtin_convertvector(v, bf16x2_t); return __builtin_bit_cast(unsigned, b); }

template <class Epi, class Sched, bool ALIGN_EPI = false, bool SP2 = false>
__device__ __forceinline__ void gemm_phase(LAS unsigned char* lds, const Gemm g, const Sched& S, const Epi& E) {
    const int tid = threadIdx.x, wid = __builtin_amdgcn_readfirstlane(tid >> 6), lane = tid & 63, wr = wid >> 2, wc = wid & 3, fr = lane & 15, fq = lane >> 4;
    const int K = g.K, nt = K / BK;
    unsigned voffA[2], voffB[2];
#pragma unroll
    for (int i = 0; i < 2; ++i) { int R, C; stage_rc(tid * 16 + i * 8192, R, C); const int Rb = Epi::PERM ? ((R & ~31) + perm32(R & 31)) : R;
        voffA[i] = (unsigned)(R * K + C) * 2u; voffB[i] = (unsigned)(Rb * K + C) * 2u; }
    const size_t kstep = (size_t)(BK * 2);
    const size_t hstep = (size_t)HALF * K * 2;
    const size_t tstep = 2 * hstep;
    const unsigned ldsw = (unsigned)wid * 1024u;
    const int aoff = lds_byte(wr * 64 + fr, fq * 8), boff = lds_byte(wc * 32 + fr, fq * 8);
#define PG8_SA(b, h) (((b) * 2 + (h)) * HTB)
#define PG8_SB(b, h) ((4 + (b) * 2 + (h)) * HTB)
#define PG8_STAGE(bufoff, gbase, voff) do { _Pragma("unroll") for (int _i = 0; _i < 2; ++_i) \
        __builtin_amdgcn_global_load_lds((const unsigned*)((const char*)(gbase) + (voff)[_i]), (LAS unsigned*)(lds + (bufoff) + ldsw + _i * 8192), 16, 0, 0); } while (0)
#define PG8_LDA(dst, b, h) do { _Pragma("unroll") for (int m = 0; m < 4; ++m) _Pragma("unroll") for (int k = 0; k < 2; ++k) dst[m][k] = *(const LAS bf16x8*)(lds + PG8_SA(b, h) + aoff + m * 2048 + k * 1024); } while (0)
#define PG8_LDB(dst, b, h) do { _Pragma("unroll") for (int n = 0; n < 2; ++n) _Pragma("unroll") for (int k = 0; k < 2; ++k) dst[n][k] = *(const LAS bf16x8*)(lds + PG8_SB(b, h) + boff + n * 2048 + k * 1024); } while (0)
#define PG8_MMA(ai, bj, At, Bt) do { __builtin_amdgcn_s_setprio(1); _Pragma("unroll") for (int m = 0; m < 4; ++m) _Pragma("unroll") for (int n = 0; n < 2; ++n) _Pragma("unroll") for (int k = 0; k < 2; ++k) \
        acc[ai][bj][m][n] = __builtin_amdgcn_mfma_f32_16x16x32_bf16(Bt[n][k], At[m][k], acc[ai][bj][m][n], 0, 0, 0); __builtin_amdgcn_s_setprio(0); } while (0)
#define PG8_WAIT_V(n) asm volatile("s_waitcnt vmcnt(" #n ")" ::: "memory")
#define PG8_WAIT_L(n) asm volatile("s_waitcnt lgkmcnt(" #n ")" ::: "memory")
#define PG8_BAR __builtin_amdgcn_s_barrier()
#define PG8_SCHED __builtin_amdgcn_sched_barrier(0)
    Unit cur, nxt; int ui = 0;
    if (!S.next(0, cur)) return;
    f32x4 acc[2][2][4][2];
#pragma unroll
    for (int a = 0; a < 2; ++a)
#pragma unroll
        for (int b = 0; b < 2; ++b)
#pragma unroll
            for (int m = 0; m < 4; ++m)
#pragma unroll
                for (int n = 0; n < 2; ++n) acc[a][b][m][n] = (f32x4){0.f, 0.f, 0.f, 0.f};
    bf16x8 At[4][2], B0[2][2], B1[2][2];
    const char* cA = (const char*)g.A + (size_t)cur.pm * tstep; const char* cB = (const char*)g.Bt + (size_t)cur.pn * tstep;
    S.a_ready(cur);
    if constexpr (SP2) {
        PG8_STAGE(PG8_SB(0, 0), cB, voffB); PG8_STAGE(PG8_SB(0, 1), cB + hstep, voffB); PG8_STAGE(PG8_SA(0, 0), cA, voffA); PG8_STAGE(PG8_SA(0, 1), cA + hstep, voffA);
        if (wr == 1) PG8_BAR;
        PG8_WAIT_V(2); PG8_BAR;
        PG8_STAGE(PG8_SB(1, 0), cB + kstep, voffB); PG8_STAGE(PG8_SA(1, 0), cA + kstep, voffA); PG8_STAGE(PG8_SB(1, 1), cB + hstep + kstep, voffB);
        PG8_WAIT_V(6); PG8_BAR;
    } else {
        PG8_STAGE(PG8_SB(0, 0), cB, voffB); PG8_STAGE(PG8_SA(0, 0), cA, voffA); PG8_STAGE(PG8_SB(0, 1), cB + hstep, voffB); PG8_STAGE(PG8_SA(0, 1), cA + hstep, voffA);
        if (wr == 1) PG8_BAR;
        PG8_WAIT_V(4); PG8_BAR;
        PG8_STAGE(PG8_SB(1, 0), cB + kstep, voffB); PG8_STAGE(PG8_SA(1, 0), cA + kstep, voffA); PG8_STAGE(PG8_SB(1, 1), cB + hstep + kstep, voffB);
        PG8_WAIT_V(6); PG8_BAR;
    }
    for (;;) {
        const bool has_next = S.next(ui + 1, nxt);
        const char* nA = has_next ? (const char*)g.A + (size_t)nxt.pm * tstep : cA; const char* nB = has_next ? (const char*)g.Bt + (size_t)nxt.pn * tstep : cB;
        for (int t = 0; t < nt; t += 2) {
            const bool last = (t == nt - 2);
            const char* a1 = cA + (size_t)(t + 1) * kstep;
            const char* a2 = last ? nA : cA + (size_t)(t + 2) * kstep; const char* b2 = last ? nB : cB + (size_t)(t + 2) * kstep;
            const char* a3 = a2 + kstep; const char* b3 = b2 + kstep;
            if (last && has_next) S.a_ready(nxt);
            if constexpr (SP2) {
            PG8_LDB(B0, 0, 0); PG8_LDB(B1, 0, 1); PG8_SCHED; PG8_LDA(At, 0, 0); PG8_STAGE(PG8_SA(1, 1), a1 + hstep, voffA);
            PG8_WAIT_V(8); PG8_WAIT_L(0); PG8_BAR; PG8_MMA(0, 0, At, B0); PG8_MMA(0, 1, At, B1); PG8_BAR; PG8_SCHED;
            PG8_LDA(At, 0, 1); PG8_STAGE(PG8_SB(0, 0), b2, voffB); PG8_STAGE(PG8_SB(0, 1), b2 + hstep, voffB); PG8_STAGE(PG8_SA(0, 0), a2, voffA);
            PG8_WAIT_V(8); PG8_WAIT_L(0); PG8_BAR; PG8_MMA(1, 0, At, B0); PG8_MMA(1, 1, At, B1); PG8_BAR; PG8_SCHED;
            PG8_LDB(B0, 1, 0); PG8_LDB(B1, 1, 1); PG8_SCHED; PG8_LDA(At, 1, 0); PG8_STAGE(PG8_SA(0, 1), a2 + hstep, voffA);
            PG8_WAIT_V(8); PG8_WAIT_L(0); PG8_BAR; PG8_MMA(0, 0, At, B0); PG8_MMA(0, 1, At, B1); PG8_BAR; PG8_SCHED;
            PG8_LDA(At, 1, 1); PG8_STAGE(PG8_SB(1, 0), b3, voffB); PG8_STAGE(PG8_SB(1, 1), b3 + hstep, voffB); PG8_STAGE(PG8_SA(1, 0), a3, voffA);
            PG8_WAIT_V(8); PG8_WAIT_L(0); PG8_BAR; PG8_MMA(1, 0, At, B0); PG8_MMA(1, 1, At, B1); PG8_BAR; PG8_SCHED;
            } else {
            PG8_LDB(B0, 0, 0); PG8_SCHED; PG8_LDA(At, 0, 0); PG8_STAGE(PG8_SA(1, 1), a1 + hstep, voffA);
            PG8_WAIT_L(8); PG8_BAR; PG8_WAIT_L(0); PG8_MMA(0, 0, At, B0); PG8_BAR; PG8_SCHED;
            PG8_LDB(B1, 0, 1); PG8_STAGE(PG8_SB(0, 0), b2, voffB);
            PG8_BAR; PG8_WAIT_L(0); PG8_MMA(0, 1, At, B1); PG8_BAR;
            PG8_LDA(At, 0, 1); PG8_STAGE(PG8_SA(0, 0), a2, voffA);
            PG8_BAR; PG8_WAIT_L(0); PG8_MMA(1, 0, At, B0); PG8_BAR; PG8_SCHED;
            PG8_STAGE(PG8_SB(0, 1), b2 + hstep, voffB);
            PG8_WAIT_V(6); PG8_BAR; PG8_MMA(1, 1, At, B1); PG8_BAR;
            PG8_LDB(B0, 1, 0); PG8_SCHED; PG8_LDA(At, 1, 0); PG8_STAGE(PG8_SA(0, 1), a2 + hstep, voffA);
            PG8_WAIT_L(8); PG8_BAR; PG8_WAIT_L(0); PG8_MMA(0, 0, At, B0); PG8_BAR; PG8_SCHED;
            PG8_LDB(B1, 1, 1); PG8_STAGE(PG8_SB(1, 0), b3, voffB);
            PG8_BAR; PG8_WAIT_L(0); PG8_MMA(0, 1, At, B1); PG8_BAR;
            PG8_LDA(At, 1, 1); PG8_STAGE(PG8_SA(1, 0), a3, voffA);
            PG8_BAR; PG8_WAIT_L(0); PG8_MMA(1, 0, At, B0); PG8_BAR; PG8_SCHED;
            PG8_STAGE(PG8_SB(1, 1), b3 + hstep, voffB);
            PG8_WAIT_V(6); PG8_BAR; PG8_MMA(1, 1, At, B1); PG8_BAR;
            }
        }
        if constexpr (ALIGN_EPI) { if (wr == 0) PG8_BAR; }
        if constexpr (!Epi::AFTER_DRAIN) { E(acc, cur, wr, wc, fr, fq); S.done(cur); }
        if (!has_next) break;
#pragma unroll
        for (int a = 0; a < 2; ++a)
#pragma unroll
            for (int b = 0; b < 2; ++b)
#pragma unroll
                for (int m = 0; m < 4; ++m)
#pragma unroll
                    for (int n = 0; n < 2; ++n) acc[a][b][m][n] = (f32x4){0.f, 0.f, 0.f, 0.f};
        cur = nxt; cA = nA; cB = nB; ++ui;
        if constexpr (ALIGN_EPI) { if (wr == 1) PG8_BAR; }
    }
    PG8_WAIT_V(0);
    if constexpr (!ALIGN_EPI) { if (wr == 0) PG8_BAR; }
    PG8_BAR;
    if constexpr (Epi::AFTER_DRAIN) { E.fused(acc, cur, wr, wc, fr, fq, lds, wid, lane); S.done(cur); }
#undef PG8_SA
#undef PG8_SB
#undef PG8_STAGE
#undef PG8_LDA
#undef PG8_LDB
#undef PG8_MMA
#undef PG8_WAIT_V
#undef PG8_WAIT_L
#undef PG8_BAR
#undef PG8_SCHED
}
}
using pg8::cvt_pk_bf16;

constexpr int M_TOK = 16384, DM = 1024, SEQ = 8192;
constexpr size_t MiB = 1u << 20;
constexpr size_t WS_ROWSQ = 128 * 1024;
constexpr size_t WS_WIN = 1 * MiB;
constexpr size_t WS_WSBHG = 21 * MiB;
constexpr size_t WS_WOUT = 25 * MiB;
constexpr size_t WS_HGD = 27 * MiB;
constexpr size_t WS_H = 28 * MiB;
constexpr size_t WS_SBQ = 60 * MiB;
constexpr size_t WS_HGQ = 92 * MiB;
constexpr size_t WS_SBK = 124 * MiB;
constexpr size_t WS_SBV = 156 * MiB;
constexpr size_t WS_HGI = 188 * MiB;
constexpr size_t WS_ST = 220 * MiB;
constexpr size_t WS_GATES = 124 * MiB;
constexpr size_t WS_Y = 188 * MiB;
constexpr size_t WS_END = 252 * MiB;
constexpr int LDS_BYTES = 163840, LDS_MISC = 163840 - 64;
constexpr float RMS_EPS = 1e-6f;

__device__ __forceinline__ float bf2f(unsigned u) { return __uint_as_float(u << 16); }
__device__ __forceinline__ unsigned f2bf(float f) { unsigned u = __float_as_uint(f); return (u + 0x7fffu + ((u >> 16) & 1u)) >> 16; }
__device__ __forceinline__ unsigned pk2(float lo, float hi) { return f2bf(lo) | (f2bf(hi) << 16); }
__device__ __forceinline__ float sigmoidf_(float v) { return __builtin_amdgcn_rcpf(1.f + __expf(-v)); }
__device__ __forceinline__ float siluf_(float v) { return v * sigmoidf_(v); }
__device__ __forceinline__ float wave_sum(float v) {
#pragma unroll
    for (int o = 1; o < 64; o <<= 1) v += __shfl_xor(v, o);
    return v;
}

struct EpiA {
    static constexpr bool AFTER_DRAIN = false;
    static constexpr bool PERM = true;
    bf16_t* sbq; bf16_t* sbk; bf16_t* sbv; bf16_t* hgq; bf16_t* hgi; float* G; const float* lbl;
    __device__ __forceinline__ void operator()(const f32x4 (&acc)[2][2][4][2], const pg8::Unit& u, int wr, int wc, int fr, int fq) const {
        const int seg = u.pn >> 2;
        const int row0 = u.pm * 256 + wr * 64 + fr, col0 = (u.pn & 3) * 256 + wc * 32 + 8 * fq;
        if (seg == 5) {
#pragma unroll
            for (int bj = 0; bj < 2; ++bj) {
                const int col = col0 + bj * 128;
                float lb[8];
#pragma unroll
                for (int j = 0; j < 8; ++j) lb[j] = __builtin_amdgcn_rcpf(1.f + __expf(lbl[1024 + col + j] - lbl[col + j]));
#pragma unroll
                for (int ai = 0; ai < 2; ++ai)
#pragma unroll
                    for (int m = 0; m < 4; ++m) {
                        bf16_t* p = (bf16_t*)G + (size_t)(row0 + ai * 128 + m * 16) * 1024 + col;
                        f32x4 a = acc[ai][bj][m][0], b = acc[ai][bj][m][1], ga, gb;
#pragma unroll
                        for (int j = 0; j < 4; ++j) { ga[j] = __logf(lb[j] + (1.f - lb[j]) * sigmoidf_(a[j])); gb[j] = __logf(lb[4 + j] + (1.f - lb[4 + j]) * sigmoidf_(b[j])); }
                        u32x4 w; w.x = cvt_pk_bf16(ga[0], ga[1]); w.y = cvt_pk_bf16(ga[2], ga[3]); w.z = cvt_pk_bf16(gb[0], gb[1]); w.w = cvt_pk_bf16(gb[2], gb[3]);
                        *(u32x4*)p = w;
                    }
            }
        } else {
            if (seg == 2) {
#pragma unroll
                for (int ai = 0; ai < 2; ++ai)
#pragma unroll
                    for (int m = 0; m < 4; ++m) {
                        const int row = row0 + ai * 128 + m * 16, bb = row >> 13, ss = row & 8191;
#pragma unroll
                        for (int bj = 0; bj < 2; ++bj) {
                            const int col = col0 + bj * 128;
                            bf16_t* p = sbv + ((size_t)(bb * 1024 + col)) * 8192 + ss;
                            const f32x4 a = acc[ai][bj][m][0], b = acc[ai][bj][m][1];
#pragma unroll
                            for (int j = 0; j < 4; ++j) { p[(size_t)j * 8192] = (bf16_t)f2bf(a[j]); p[(size_t)(4 + j) * 8192] = (bf16_t)f2bf(b[j]); }
                        }
                    }
                return;
            }
            bf16_t* base = seg == 0 ? sbq : seg == 1 ? sbk : seg == 2 ? sbv : seg == 4 ? hgq : hgi;
            const float sc = seg == 0 ? 0.08838834764831845f : 1.f; const bool act = seg == 4;
#pragma unroll
            for (int ai = 0; ai < 2; ++ai)
#pragma unroll
                for (int m = 0; m < 4; ++m)
#pragma unroll
                    for (int bj = 0; bj < 2; ++bj) {
                        f32x4 a = acc[ai][bj][m][0], b = acc[ai][bj][m][1];
                        if (act) {
#pragma unroll
                            for (int j = 0; j < 4; ++j) { a[j] = siluf_(a[j]); b[j] = siluf_(b[j]); } }
                        a = a * sc; b = b * sc;
                        u32x4 w; w.x = cvt_pk_bf16(a[0], a[1]); w.y = cvt_pk_bf16(a[2], a[3]); w.z = cvt_pk_bf16(b[0], b[1]); w.w = cvt_pk_bf16(b[2], b[3]);
                        *(u32x4*)(base + (size_t)(row0 + ai * 128 + m * 16) * 1024 + col0 + bj * 128) = w;
                    }
        }
    }
};
struct EpiB {
    static constexpr bool AFTER_DRAIN = false;
    static constexpr bool PERM = true;
    bf16_t* asb; bf16_t* ahg; bf16_t* gates; const float* bgate;
    __device__ __forceinline__ void operator()(const f32x4 (&acc)[2][2][4][2], const pg8::Unit& u, int wr, int wc, int fr, int fq) const {
        const int seg = u.pn >> 2;
        const int row0 = u.pm * 256 + wr * 64 + fr, col0 = (u.pn & 3) * 256 + wc * 32 + 8 * fq;
        if (seg >= 8) {
#pragma unroll
            for (int bj = 0; bj < 2; ++bj) {
                const int col = (seg - 8) * 1024 + col0 + bj * 128;
                const f32x4 b0 = *(const f32x4*)(bgate + col), b1 = *(const f32x4*)(bgate + col + 4);
#pragma unroll
                for (int ai = 0; ai < 2; ++ai)
#pragma unroll
                    for (int m = 0; m < 4; ++m) {
                        f32x4 a = acc[ai][bj][m][0] + b0, b = acc[ai][bj][m][1] + b1;
#pragma unroll
                        for (int j = 0; j < 4; ++j) { a[j] = sigmoidf_(a[j]); b[j] = sigmoidf_(b[j]); }
                        u32x4 w; w.x = cvt_pk_bf16(a[0], a[1]); w.y = cvt_pk_bf16(a[2], a[3]); w.z = cvt_pk_bf16(b[0], b[1]); w.w = cvt_pk_bf16(b[2], b[3]);
                        *(u32x4*)(gates + (size_t)(row0 + ai * 128 + m * 16) * 2048 + col) = w;
                    }
            }
        } else {
            bf16_t* base = seg == 3 ? asb : ahg;
#pragma unroll
            for (int ai = 0; ai < 2; ++ai) {
                u32x4 ov[4][2];
#pragma unroll
                for (int m = 0; m < 4; ++m)
#pragma unroll
                    for (int bj = 0; bj < 2; ++bj) ov[m][bj] = *(const u32x4*)(base + (size_t)(row0 + ai * 128 + m * 16) * 1024 + col0 + bj * 128);
#pragma unroll
                for (int m = 0; m < 4; ++m)
#pragma unroll
                    for (int bj = 0; bj < 2; ++bj) {
                        const u32x4 o = ov[m][bj];
                        const f32x4 a = acc[ai][bj][m][0], b = acc[ai][bj][m][1];
                        u32x4 w;
                        w.x = cvt_pk_bf16(bf2f(o.x & 0xffffu) * siluf_(a[0]), bf2f(o.x >> 16) * siluf_(a[1]));
                        w.y = cvt_pk_bf16(bf2f(o.y & 0xffffu) * siluf_(a[2]), bf2f(o.y >> 16) * siluf_(a[3]));
                        w.z = cvt_pk_bf16(bf2f(o.z & 0xffffu) * siluf_(b[0]), bf2f(o.z >> 16) * siluf_(b[1]));
                        w.w = cvt_pk_bf16(bf2f(o.w & 0xffffu) * siluf_(b[2]), bf2f(o.w >> 16) * siluf_(b[3]));
                        *(u32x4*)(base + (size_t)(row0 + ai * 128 + m * 16) * 1024 + col0 + bj * 128) = w;
                    }
            }
        }
    }
};
struct EpiC {
    static constexpr bool AFTER_DRAIN = false;
    static constexpr bool PERM = true;
    const bf16_t* gates; float* tmp; bf16_t* Y;
    __device__ __forceinline__ void operator()(const f32x4 (&acc)[2][2][4][2], const pg8::Unit& u, int wr, int wc, int fr, int fq) const {
        const bool second = u.pm >= 64;
        const int pm = second ? u.pm - 64 : u.pm, pn = second ? u.pn - 4 : u.pn;
        const int row0 = pm * 256 + wr * 64 + fr, col0 = pn * 256 + wc * 32 + 8 * fq;
#pragma unroll
        for (int ai = 0; ai < 2; ++ai)
#pragma unroll
        for (int mh = 0; mh < 2; ++mh) {
            u32x4 gv[2][2], tv[2][2];
#pragma unroll
            for (int mm = 0; mm < 2; ++mm)
#pragma unroll
                for (int bj = 0; bj < 2; ++bj) {
                    const size_t row = (size_t)(row0 + ai * 128 + (2 * mh + mm) * 16); const int col = col0 + bj * 128;
                    gv[mm][bj] = *(const u32x4*)(gates + row * 2048 + (second ? 1024 : 0) + col);
                    if (second) tv[mm][bj] = *(const u32x4*)((const bf16_t*)tmp + row * 1024 + col);
                }
#pragma unroll
            for (int mm = 0; mm < 2; ++mm)
#pragma unroll
                for (int bj = 0; bj < 2; ++bj) {
                    const int m = 2 * mh + mm;
                    const size_t row = (size_t)(row0 + ai * 128 + m * 16); const int col = col0 + bj * 128;
                    const u32x4 gt = gv[mm][bj];
                    f32x4 a = acc[ai][bj][m][0], b = acc[ai][bj][m][1];
                    a[0] *= bf2f(gt.x & 0xffffu); a[1] *= bf2f(gt.x >> 16); a[2] *= bf2f(gt.y & 0xffffu); a[3] *= bf2f(gt.y >> 16);
                    b[0] *= bf2f(gt.z & 0xffffu); b[1] *= bf2f(gt.z >> 16); b[2] *= bf2f(gt.w & 0xffffu); b[3] *= bf2f(gt.w >> 16);
                    if (!second) { u32x4 w; w.x = cvt_pk_bf16(a[0], a[1]); w.y = cvt_pk_bf16(a[2], a[3]); w.z = cvt_pk_bf16(b[0], b[1]); w.w = cvt_pk_bf16(b[2], b[3]); *(u32x4*)((bf16_t*)tmp + row * 1024 + col) = w; }
                    else {
                        { const u32x4 t = tv[mm][bj]; a[0] += bf2f(t.x & 0xffffu); a[1] += bf2f(t.x >> 16); a[2] += bf2f(t.y & 0xffffu); a[3] += bf2f(t.y >> 16);
                          b[0] += bf2f(t.z & 0xffffu); b[1] += bf2f(t.z >> 16); b[2] += bf2f(t.w & 0xffffu); b[3] += bf2f(t.w >> 16); }
                        u32x4 w; w.x = cvt_pk_bf16(a[0], a[1]); w.y = cvt_pk_bf16(a[2], a[3]); w.z = cvt_pk_bf16(b[0], b[1]); w.w = cvt_pk_bf16(b[2], b[3]);
                        *(u32x4*)(Y + row * 1024 + col) = w;
                    }
                }
        }
    }
};
struct EpiD {
    static constexpr bool PERM = true, AFTER_DRAIN = true;
    const float* x; float* out; const float* fng; float* xb; unsigned* cnt;
    __device__ __forceinline__ void operator()(const f32x4 (&)[2][2][4][2], const pg8::Unit&, int, int, int, int) const {}
    __device__ __forceinline__ void fused(f32x4 (&acc)[2][2][4][2], const pg8::Unit& u, int wr, int wc, int fr, int fq, LAS unsigned char* lds, int wid, int lane) const {
        const int tid = threadIdx.x;
        const int row0 = u.pm * 256 + wr * 64 + fr, col0 = u.pn * 256 + wc * 32 + 8 * fq;
        LAS float* P = (LAS float*)lds;
        LAS float* Sr = (LAS float*)(lds + 4096);
#pragma unroll
        for (int ai = 0; ai < 2; ++ai) {
            f32x4 xa[4][2], xc[4][2];
#pragma unroll
            for (int m = 0; m < 4; ++m)
#pragma unroll
                for (int bj = 0; bj < 2; ++bj) {
                    const size_t off = (size_t)(row0 + ai * 128 + m * 16) * 1024 + col0 + bj * 128;
                    xa[m][bj] = *(const f32x4*)(x + off); xc[m][bj] = *(const f32x4*)(x + off + 4);
                }
#pragma unroll
            for (int m = 0; m < 4; ++m) {
                float ss = 0.f;
#pragma unroll
                for (int bj = 0; bj < 2; ++bj) {
                    const f32x4 a = acc[ai][bj][m][0] + xa[m][bj], b = acc[ai][bj][m][1] + xc[m][bj];
                    acc[ai][bj][m][0] = a; acc[ai][bj][m][1] = b;
                    ss += (a[0] * a[0] + a[1] * a[1]) + (a[2] * a[2] + a[3] * a[3]) + (b[0] * b[0] + b[1] * b[1]) + (b[2] * b[2] + b[3] * b[3]);
                }
                ss += __shfl_xor(ss, 16); ss += __shfl_xor(ss, 32);
                if (fq == 0) P[(ai * 128 + wr * 64 + m * 16 + fr) * 4 + wc] = ss;
            }
        }
        __syncthreads();
        if (tid < 256) {
            const float t = (P[tid * 4] + P[tid * 4 + 1]) + (P[tid * 4 + 2] + P[tid * 4 + 3]);
            __hip_atomic_store(xb + ((size_t)(u.pm * 4 + u.pn)) * 256 + tid, t, __ATOMIC_RELAXED, __HIP_MEMORY_SCOPE_AGENT);
        }
        asm volatile("s_waitcnt vmcnt(0)" ::: "memory");
        __syncthreads();
        if (tid == 0) {
            unsigned* c = cnt + 64 * u.pm;
            (void)__hip_atomic_fetch_add(c, 1u, __ATOMIC_RELAXED, __HIP_MEMORY_SCOPE_AGENT);
            unsigned sp = 0;
            while (__hip_atomic_load(c, __ATOMIC_RELAXED, __HIP_MEMORY_SCOPE_AGENT) < 4u) { __builtin_amdgcn_s_sleep(2); if (++sp > (1u << 22)) break; }
            __builtin_amdgcn_fence(__ATOMIC_ACQUIRE, "agent");
            asm volatile("s_waitcnt vmcnt(0)" ::: "memory");
        }
        __syncthreads();
        if (tid < 256) {
            float t = 0.f;
#pragma unroll
            for (int pn = 0; pn < 4; ++pn) t += __hip_atomic_load(xb + ((size_t)(u.pm * 4 + pn)) * 256 + tid, __ATOMIC_RELAXED, __HIP_MEMORY_SCOPE_AGENT);
            Sr[tid] = __builtin_amdgcn_rsqf(t * (1.f / 1024.f) + RMS_EPS);
        }
        __syncthreads();
#pragma unroll
        for (int bj = 0; bj < 2; ++bj) {
            const f32x4 g0 = *(const f32x4*)(fng + col0 + bj * 128), g1 = *(const f32x4*)(fng + col0 + bj * 128 + 4);
#pragma unroll
            for (int ai = 0; ai < 2; ++ai)
#pragma unroll
                for (int m = 0; m < 4; ++m) {
                    const float rstd = Sr[ai * 128 + wr * 64 + m * 16 + fr];
                    const size_t off = (size_t)(row0 + ai * 128 + m * 16) * 1024 + col0 + bj * 128;
                    *(f32x4*)(out + off) = acc[ai][bj][m][0] * rstd * g0; *(f32x4*)(out + off + 4) = acc[ai][bj][m][1] * rstd * g1;
                }
        }
    }
};

__device__ __forceinline__ void p0_transpose_kn(const float* W, int K, int N, bf16_t* WT, int row_off, LAS float* scr, int kb, int nb, int lane) {
    const int k0 = 64 * kb, n0 = 32 * nb;
    float wv[32];
#pragma unroll
    for (int i = 0; i < 32; ++i) wv[i] = W[(size_t)(k0 + 2 * i + (lane >> 5)) * N + n0 + (lane & 31)];
#pragma unroll
    for (int i = 0; i < 32; ++i) scr[(2 * i + (lane >> 5)) * 33 + (lane & 31)] = wv[i];
    asm volatile("s_waitcnt lgkmcnt(0)" ::: "memory");
    const int c = lane & 7;
#pragma unroll
    for (int j = 0; j < 4; ++j) { const int n = (lane >> 3) + 8 * j; const LAS float* s = scr + (8 * c) * 33 + n;
        u32x4 o; o.x = pk2(s[0 * 33], s[1 * 33]); o.y = pk2(s[2 * 33], s[3 * 33]); o.z = pk2(s[4 * 33], s[5 * 33]); o.w = pk2(s[6 * 33], s[7 * 33]);
        *(u32x4*)(WT + (size_t)(row_off + n0 + n) * K + k0 + 8 * c) = o; }
    asm volatile("s_waitcnt lgkmcnt(0)" ::: "memory");
}

constexpr int SB_KW = 0, SB_VW = 69632, SB_ZS = 137216;
__device__ __forceinline__ void sb_unit(LAS unsigned char* lds, int unit, bf16_t* Q, const bf16_t* Kb, const bf16_t* VT) {
    const int tid = threadIdx.x, lane = tid & 63, w = tid >> 6, r = lane & 15, g = lane >> 4;
    const int bh = unit >> 6, qb = unit & 63, b = bh >> 3, h = bh & 7;
    const size_t rowbase = (size_t)b * SEQ;
    const int tblk = qb * 128, kwin0 = tblk >= 128 ? tblk - 128 : 0;
    LAS bf16_t* Kw = (LAS bf16_t*)(lds + SB_KW);
    LAS bf16_t* Vw = (LAS bf16_t*)(lds + SB_VW);
    LAS float* Zs = (LAS float*)(lds + SB_ZS) + w * (16 * 36);
    {
        u32x4 kv[8], vv[8];
#pragma unroll
        for (int i = 0; i < 8; ++i) { const int c = tid + 512 * i, key = c >> 4, dc = c & 15;
            kv[i] = *(const u32x4*)(Kb + (rowbase + kwin0 + key) * 1024 + h * 128 + 8 * dc); }
#pragma unroll
        for (int i = 0; i < 8; ++i) { const int c = tid + 512 * i, row = c >> 5, kc = c & 31;
            vv[i] = *(const u32x4*)(VT + ((size_t)(bh * 128 + row)) * 8192 + kwin0 + 8 * kc); }
        __syncthreads();
#pragma unroll
        for (int i = 0; i < 8; ++i) { const int c = tid + 512 * i, key = c >> 4, dc = c & 15; *(LAS u32x4*)(Kw + key * 136 + 8 * dc) = kv[i]; }
#pragma unroll
        for (int i = 0; i < 8; ++i) { const int c = tid + 512 * i, row = c >> 5, kc = c & 31; *(LAS u32x4*)(Vw + row * 264 + 8 * kc) = vv[i]; }
    }
    const int t0 = tblk + 16 * w;
    bf16x8 qf[4];
    {
        const bf16_t* qrow = Q + (rowbase + t0 + r) * 1024 + h * 128 + 8 * g;
#pragma unroll
        for (int kk = 0; kk < 4; ++kk) qf[kk] = *(const bf16x8*)(qrow + 32 * kk);
    }
    f32x4 o[8];
#pragma unroll
    for (int n = 0; n < 8; ++n) o[n] = (f32x4){0.f, 0.f, 0.f, 0.f};
    float sacc = 1.f;
    const int t_abs = t0 + r;
    const bf16_t* kbase = Kb + (rowbase + r) * 1024 + h * 128 + 8 * g;
    const bf16_t* vbase = VT + ((size_t)(bh * 128 + r)) * 8192 + 8 * g;
    __syncthreads();
    for (int kt = (t0 + 15) >> 5; kt >= 0; --kt) {
        const int key0 = 32 * kt;
        bf16x8 kf[8]; u32x2 vlo[8], vhi[8];
        if (key0 >= kwin0) {
            const LAS bf16_t* kp = Kw + (key0 - kwin0 + r) * 136 + 8 * g;
            const LAS bf16_t* vp = Vw + r * 264 + (key0 - kwin0) + 4 * g;
#pragma unroll
            for (int n = 0; n < 2; ++n)
#pragma unroll
                for (int kk = 0; kk < 4; ++kk) kf[4 * n + kk] = *(const LAS bf16x8*)(kp + (16 * n) * 136 + 32 * kk);
#pragma unroll
            for (int n = 0; n < 8; ++n) { vlo[n] = *(const LAS u32x2*)(vp + (16 * n) * 264); vhi[n] = *(const LAS u32x2*)(vp + (16 * n) * 264 + 16); }
        } else {
#pragma unroll
            for (int n = 0; n < 2; ++n)
#pragma unroll
                for (int kk = 0; kk < 4; ++kk) kf[4 * n + kk] = *(const bf16x8*)(kbase + (size_t)(key0 + 16 * n) * 1024 + 32 * kk);
            const bf16_t* vg = VT + ((size_t)(bh * 128 + r)) * 8192 + key0 + 4 * g;
#pragma unroll
            for (int n = 0; n < 8; ++n) { vlo[n] = *(const u32x2*)(vg + (size_t)(16 * n) * 8192); vhi[n] = *(const u32x2*)(vg + (size_t)(16 * n) * 8192 + 16); }
        }
        float zz[8];
#pragma unroll
        for (int n = 0; n < 2; ++n) {
            f32x4 z = (f32x4){0.f, 0.f, 0.f, 0.f};
#pragma unroll
            for (int kk = 0; kk < 4; ++kk) z = __builtin_amdgcn_mfma_f32_16x16x32_bf16(kf[4 * n + kk], qf[kk], z, 0, 0, 0);
            zz[4 * n] = z[0]; zz[4 * n + 1] = z[1]; zz[4 * n + 2] = z[2]; zz[4 * n + 3] = z[3];
        }
        bf16x8 afr;
        {
            float qs[8], bs[8];
            float T0 = 1.f, T1 = 1.f;
#pragma unroll
            for (int e = 0; e < 8; ++e) {
                const float ex = __expf(-fabsf(zz[e])), rr = __builtin_amdgcn_rcpf(1.f + ex), er = ex * rr;
                const bool pos = zz[e] >= 0.f, valid = (key0 + 16 * (e >> 2) + 4 * g + (e & 3)) < t_abs;
                bs[e] = valid ? (pos ? rr : er) : 0.f;
                qs[e] = valid ? (pos ? er : rr) : 1.f;
            }
            T0 = (qs[0] * qs[1]) * (qs[2] * qs[3]); T1 = (qs[4] * qs[5]) * (qs[6] * qs[7]);
            const float a1 = __shfl_xor(T1, 16), b1 = __shfl_xor(T1, 32), c1 = __shfl_xor(a1, 32);
            const float a0 = __shfl_xor(T0, 16), b0 = __shfl_xor(T0, 32), c0 = __shfl_xor(a0, 32);
            const float after1 = (g == 0) ? (a1 * b1 * c1) : (g == 1) ? (b1 * c1) : (g == 2) ? a1 : 1.f;
            const float after0 = (g == 0) ? (a0 * b0 * c0) : (g == 1) ? (b0 * c0) : (g == 2) ? a0 : 1.f;
            const float all1 = (T1 * a1) * (b1 * c1), all0 = (T0 * a0) * (b0 * c0);
            float w[8];
            float p1 = sacc * after1;
#pragma unroll
            for (int q = 3; q >= 0; --q) { w[4 + q] = bs[4 + q] * p1; p1 *= qs[4 + q]; }
            float p0 = (sacc * all1) * after0;
#pragma unroll
            for (int q = 3; q >= 0; --q) { w[q] = bs[q] * p0; p0 *= qs[q]; }
            afr = __builtin_bit_cast(bf16x8, ((u32x4){cvt_pk_bf16(w[0], w[1]), cvt_pk_bf16(w[2], w[3]), cvt_pk_bf16(w[4], w[5]), cvt_pk_bf16(w[6], w[7])}));
            sacc *= all1 * all0;
        }
#pragma unroll
        for (int n = 0; n < 8; ++n) {
            const bf16x8 vf = __builtin_bit_cast(bf16x8, ((u32x4){vlo[n].x, vlo[n].y, vhi[n].x, vhi[n].y}));
            o[n] = __builtin_amdgcn_mfma_f32_16x16x32_bf16(afr, vf, o[n], 0, 0, 0);
        }
        float mx = sacc;
        mx = fmaxf(mx, __builtin_bit_cast(float, __builtin_amdgcn_update_dpp(0, __builtin_bit_cast(int, mx), 0x121, 0xF, 0xF, false)));
        mx = fmaxf(mx, __builtin_bit_cast(float, __builtin_amdgcn_update_dpp(0, __builtin_bit_cast(int, mx), 0x122, 0xF, 0xF, false)));
        mx = fmaxf(mx, __builtin_bit_cast(float, __builtin_amdgcn_update_dpp(0, __builtin_bit_cast(int, mx), 0x124, 0xF, 0xF, false)));
        mx = fmaxf(mx, __builtin_bit_cast(float, __builtin_amdgcn_update_dpp(0, __builtin_bit_cast(int, mx), 0x128, 0xF, 0xF, false)));
        if (mx == 0.f) break;
    }
#pragma unroll
    for (int n = 0; n < 8; ++n)
#pragma unroll
        for (int rg = 0; rg < 4; ++rg)
            Q[(rowbase + t0 + 4 * g + rg) * 1024 + h * 128 + 16 * n + r] = (bf16_t)f2bf(o[n][rg]);
}

__device__ __forceinline__ void grp_arrive(unsigned* c) {
    asm volatile("s_waitcnt vmcnt(0)" ::: "memory");
    __syncthreads();
    if (threadIdx.x == 0) (void)__hip_atomic_fetch_add(c, 1u, __ATOMIC_RELAXED, __HIP_MEMORY_SCOPE_AGENT);
}
__device__ __forceinline__ void grp_wait(unsigned* c, unsigned target) {
    if (threadIdx.x == 0) {
        unsigned sp = 0;
        while (__hip_atomic_load(c, __ATOMIC_RELAXED, __HIP_MEMORY_SCOPE_AGENT) < target) { __builtin_amdgcn_s_sleep(2); if (++sp > (1u << 22)) break; }
        __builtin_amdgcn_fence(__ATOMIC_ACQUIRE, "agent");
        asm volatile("s_waitcnt vmcnt(0)" ::: "memory");
    }
    __syncthreads();
}

constexpr int HG_QT = 0, HG_KT = 17408, HG_KD = 34816, HG_VT = 53248, HG_AS = 71680, HG_SP = 80896, HG_PT = 115712, HG_DL = 117760, HG_DM = 118272;
struct HgRegs { float gv[16]; unsigned vv[16]; unsigned qv[16]; };
template <bool FULL>
__device__ __forceinline__ void hg_load(HgRegs& R, size_t m0, int h, const float* G, const bf16_t* HQ, const bf16_t* HI) {
    const int tid = threadIdx.x, k = tid & 127, part = tid >> 7;
    const size_t base = (m0 + 16 * part) * 1024 + h * 128 + k;
#pragma unroll
    for (int i = 0; i < 16; ++i) R.gv[i] = bf2f(((const bf16_t*)G)[base + (size_t)i * 1024]);
#pragma unroll
    for (int i = 0; i < 16; ++i) R.vv[i] = HI[base + (size_t)i * 1024];
    if (FULL) {
#pragma unroll
        for (int i = 0; i < 16; ++i) R.qv[i] = HQ[base + (size_t)i * 1024];
    }
}
template <bool FULL>
__device__ __forceinline__ float hg_prep(LAS unsigned char* lds, const HgRegs& R) {
    const int tid = threadIdx.x, k = tid & 127, part = tid >> 7;
    LAS float* ptot = (LAS float*)(lds + HG_PT);
    float gv[16], cs[16];
    float run = 0.f;
#pragma unroll
    for (int i = 0; i < 16; ++i) { gv[i] = R.gv[i]; run += gv[i]; cs[i] = run; }
    ptot[part * 128 + k] = run;
    unsigned vv[16];
#pragma unroll
    for (int i = 0; i < 16; ++i) vv[i] = R.vv[i];
    __syncthreads();
    const float p0 = ptot[k], p1 = ptot[128 + k], p2 = ptot[256 + k], p3 = ptot[384 + k];
    const float off = (part == 0) ? 0.f : (part == 1) ? p0 : (part == 2) ? (p0 + p1) : (p0 + p1 + p2);
    const float last = (p0 + p1) + (p2 + p3), mid = p0 + p1;
    LAS bf16_t* kdT = (LAS bf16_t*)(lds + HG_KD);
    LAS bf16_t* vT = (LAS bf16_t*)(lds + HG_VT);
    unsigned pk[8];
    float kkv[16], em[16];
    const float clm = __expf(last - mid);
#pragma unroll
    for (int i = 0; i < 16; ++i) { kkv[i] = 1.f - __expf(gv[i]); em[i] = __expf((FULL ? mid : last) - (cs[i] + off)); }
#pragma unroll
    for (int i = 0; i < 8; ++i) {
        const float a = kkv[2 * i] * em[2 * i] * (FULL ? clm : 1.f), c = kkv[2 * i + 1] * em[2 * i + 1] * (FULL ? clm : 1.f);
        pk[i] = cvt_pk_bf16(a, c);
    }
    *(LAS u32x4*)(kdT + k * 72 + 16 * part) = (u32x4){pk[0], pk[1], pk[2], pk[3]};
    *(LAS u32x4*)(kdT + k * 72 + 16 * part + 8) = (u32x4){pk[4], pk[5], pk[6], pk[7]};
    *(LAS u32x4*)(vT + k * 72 + 16 * part) = (u32x4){vv[0] | (vv[1] << 16), vv[2] | (vv[3] << 16), vv[4] | (vv[5] << 16), vv[6] | (vv[7] << 16)};
    *(LAS u32x4*)(vT + k * 72 + 16 * part + 8) = (u32x4){vv[8] | (vv[9] << 16), vv[10] | (vv[11] << 16), vv[12] | (vv[13] << 16), vv[14] | (vv[15] << 16)};
    if (FULL) {
        LAS bf16_t* qt = (LAS bf16_t*)(lds + HG_QT);
        LAS bf16_t* kt = (LAS bf16_t*)(lds + HG_KT);
#pragma unroll
        for (int i = 0; i < 16; ++i) {
            const float q = bf2f(R.qv[i]);
            qt[(16 * part + i) * 136 + k] = (bf16_t)f2bf(q * __builtin_amdgcn_rcpf(em[i]));
            kt[(16 * part + i) * 136 + k] = (bf16_t)f2bf(kkv[i] * em[i]);
        }
    }
    if (part == 0) { ((LAS float*)(lds + HG_DL))[k] = __expf(last); if (FULL) ((LAS float*)(lds + HG_DM))[k] = __expf(mid); }
    return last;
}
__device__ __forceinline__ void hg_state_update(LAS unsigned char* lds, f32x4 (&S)[8], int w, int r, int g) {
    const LAS bf16_t* kdT = (const LAS bf16_t*)(lds + HG_KD);
    const LAS bf16_t* vT = (const LAS bf16_t*)(lds + HG_VT);
    const LAS float* dl = (const LAS float*)(lds + HG_DL);
    const bf16x8 b0 = *(const LAS bf16x8*)(vT + (16 * w + r) * 72 + 8 * g), b1 = *(const LAS bf16x8*)(vT + (16 * w + r) * 72 + 32 + 8 * g);
#pragma unroll
    for (int i = 0; i < 8; ++i) {
        const f32x4 d = *(const LAS f32x4*)(dl + 16 * i + 4 * g);
        S[i] = S[i] * d;
        const bf16x8 a0 = *(const LAS bf16x8*)(kdT + (16 * i + r) * 72 + 8 * g), a1 = *(const LAS bf16x8*)(kdT + (16 * i + r) * 72 + 32 + 8 * g);
        S[i] = __builtin_amdgcn_mfma_f32_16x16x32_bf16(a0, b0, S[i], 0, 0, 0);
        S[i] = __builtin_amdgcn_mfma_f32_16x16x32_bf16(a1, b1, S[i], 0, 0, 0);
    }
}
__device__ __forceinline__ void hg_unit_a(LAS unsigned char* lds, int unit, const float* G, const bf16_t* HI, float* ST, float* DG, unsigned* cnt) {
    const int tid = threadIdx.x, lane = tid & 63, w = tid >> 6, r = lane & 15, g = lane >> 4;
    const int bh = unit >> 5, c = unit & 31, b = bh >> 3, h = bh & 7;
    f32x4 S[8];
#pragma unroll
    for (int i = 0; i < 8; ++i) S[i] = (f32x4){0.f, 0.f, 0.f, 0.f};
    float cumtot = 0.f;
    HgRegs R;
    const size_t mu = (size_t)b * SEQ + c * 256;
    hg_load<false>(R, mu, h, G, nullptr, HI);
    for (int sc = 0; sc < 4; ++sc) {
        __syncthreads();
        cumtot += hg_prep<false>(lds, R);
        if (sc < 3) hg_load<false>(R, mu + (sc + 1) * 64, h, G, nullptr, HI);
        __syncthreads();
        hg_state_update(lds, S, w, r, g);
    }
    float* U = ST + (size_t)unit * 16384;
#pragma unroll
    for (int i = 0; i < 8; ++i)
#pragma unroll
        for (int rg = 0; rg < 4; ++rg) __hip_atomic_store(&U[(16 * i + 4 * g + rg) * 128 + 16 * w + r], S[i][rg], __ATOMIC_RELAXED, __HIP_MEMORY_SCOPE_AGENT);
    if (tid < 128) __hip_atomic_store(&DG[unit * 128 + tid], __expf(cumtot), __ATOMIC_RELAXED, __HIP_MEMORY_SCOPE_AGENT);
    if (cnt) grp_arrive(cnt + 64 * bh);
}
__device__ __forceinline__ void hg_unit_c(LAS unsigned char* lds, int unit, const float* G, bf16_t* HQ, const bf16_t* HI, const float* ST, const float* ng) {
    const int tid = threadIdx.x, lane = tid & 63, w = tid >> 6, r = lane & 15, g = lane >> 4;
    const int bh = unit >> 5, c = unit & 31, b = bh >> 3, h = bh & 7;
    f32x4 S[8];
    {
        const float* U = ST + (size_t)unit * 16384;
#pragma unroll
        for (int i = 0; i < 8; ++i)
#pragma unroll
            for (int rg = 0; rg < 4; ++rg) S[i][rg] = U[(16 * i + 4 * g + rg) * 128 + 16 * w + r];
    }
    LAS bf16_t* qt = (LAS bf16_t*)(lds + HG_QT);
    LAS bf16_t* kt = (LAS bf16_t*)(lds + HG_KT);
    LAS bf16_t* vT = (LAS bf16_t*)(lds + HG_VT);
    LAS bf16_t* As = (LAS bf16_t*)(lds + HG_AS);
    LAS bf16_t* SpT = (LAS bf16_t*)(lds + HG_SP) + w * (16 * 136);
    LAS float* Os = (LAS float*)(lds + HG_QT);
    const LAS float* dm = (const LAS float*)(lds + HG_DM);
    HgRegs R;
    hg_load<true>(R, (size_t)b * SEQ + c * 256, h, G, HQ, HI);
    for (int sc = 0; sc < 4; ++sc) {
        const size_t m0 = (size_t)b * SEQ + c * 256 + sc * 64;
        __syncthreads();
        (void)hg_prep<true>(lds, R);
        if (sc < 3) hg_load<true>(R, m0 + 64, h, G, HQ, HI);
        __syncthreads();
#pragma unroll
        for (int i = 0; i < 8; ++i) {
            const f32x4 d = *(const LAS f32x4*)(dm + 16 * i + 4 * g);
            const f32x4 s = S[i] * d;
            *(LAS u32x2*)(SpT + r * 136 + 16 * i + 4 * g) = (u32x2){cvt_pk_bf16(s[0], s[1]), cvt_pk_bf16(s[2], s[3])};
        }
#pragma unroll
        for (int tt = 0; tt < 2; ++tt) {
            const int tile = 2 * w + tt, ti = tile >> 2, si = tile & 3;
            f32x4 a = (f32x4){0.f, 0.f, 0.f, 0.f};
            if (si <= ti) {
#pragma unroll
                for (int kk = 0; kk < 4; ++kk) {
                    const bf16x8 af = *(const LAS bf16x8*)(qt + (16 * ti + r) * 136 + 32 * kk + 8 * g);
                    const bf16x8 bf = *(const LAS bf16x8*)(kt + (16 * si + r) * 136 + 32 * kk + 8 * g);
                    a = __builtin_amdgcn_mfma_f32_16x16x32_bf16(af, bf, a, 0, 0, 0);
                }
            }
#pragma unroll
            for (int rg = 0; rg < 4; ++rg) {
                const int t = 16 * ti + 4 * g + rg, s = 16 * si + r;
                As[t * 72 + s] = (bf16_t)f2bf((s <= t) ? a[rg] : 0.f);
            }
        }
        __syncthreads();
        f32x4 o[4];
        {
            const bf16x8 vb0 = *(const LAS bf16x8*)(vT + (16 * w + r) * 72 + 8 * g), vb1 = *(const LAS bf16x8*)(vT + (16 * w + r) * 72 + 32 + 8 * g);
            bf16x8 sb[4];
#pragma unroll
            for (int kk = 0; kk < 4; ++kk) sb[kk] = *(const LAS bf16x8*)(SpT + r * 136 + 32 * kk + 8 * g);
#pragma unroll
            for (int ti = 0; ti < 4; ++ti) {
                f32x4 a = (f32x4){0.f, 0.f, 0.f, 0.f};
                const bf16x8 a0 = *(const LAS bf16x8*)(As + (16 * ti + r) * 72 + 8 * g), a1 = *(const LAS bf16x8*)(As + (16 * ti + r) * 72 + 32 + 8 * g);
                a = __builtin_amdgcn_mfma_f32_16x16x32_bf16(a0, vb0, a, 0, 0, 0);
                a = __builtin_amdgcn_mfma_f32_16x16x32_bf16(a1, vb1, a, 0, 0, 0);
#pragma unroll
                for (int kk = 0; kk < 4; ++kk) {
                    const bf16x8 qf = *(const LAS bf16x8*)(qt + (16 * ti + r) * 136 + 32 * kk + 8 * g);
                    a = __builtin_amdgcn_mfma_f32_16x16x32_bf16(qf, sb[kk], a, 0, 0, 0);
                }
                o[ti] = a;
            }
        }
        hg_state_update(lds, S, w, r, g);
        __syncthreads();
#pragma unroll
        for (int ti = 0; ti < 4; ++ti)
#pragma unroll
            for (int rg = 0; rg < 4; ++rg) Os[(16 * ti + 4 * g + rg) * 132 + 16 * w + r] = o[ti][rg];
        __syncthreads();
        {
            const int t = tid >> 3, sg = tid & 7;
            f32x4 v[4]; float ss = 0.f;
#pragma unroll
            for (int i = 0; i < 4; ++i) { v[i] = *(const LAS f32x4*)(Os + t * 132 + 16 * sg + 4 * i); ss += (v[i][0] * v[i][0] + v[i][1] * v[i][1]) + (v[i][2] * v[i][2] + v[i][3] * v[i][3]); }
            ss += __shfl_xor(ss, 1); ss += __shfl_xor(ss, 2); ss += __shfl_xor(ss, 4);
            const float rstd = __builtin_amdgcn_rsqf(ss * (1.f / 128.f) + RMS_EPS);
            const float* gp = ng + h * 128 + 16 * sg;
            unsigned pk[8];
#pragma unroll
            for (int i = 0; i < 4; ++i) {
                const f32x4 gg = *(const f32x4*)(gp + 4 * i);
                pk[2 * i] = cvt_pk_bf16(v[i][0] * rstd * gg[0], v[i][1] * rstd * gg[1]);
                pk[2 * i + 1] = cvt_pk_bf16(v[i][2] * rstd * gg[2], v[i][3] * rstd * gg[3]);
            }
            bf16_t* op = HQ + (m0 + t) * 1024 + h * 128 + 16 * sg;
            *(u32x4*)op = (u32x4){pk[0], pk[1], pk[2], pk[3]};
            *(u32x4*)(op + 8) = (u32x4){pk[4], pk[5], pk[6], pk[7]};
        }
    }
}

#define XB_TMO      128
#define XB_XCNT(j)  (256  + 64 * (j))
#define XB_XSUB(j)  (1280 + 64 * (j))
#define XB_XGEN(j)  (2304 + 64 * (j))
#define XB_TOP      3328
#define XB_TOPGEN   3392
#define XCD_BAR_WORDS 3456
#define XB_SPIN_CAP (1u << 18)
__device__ __forceinline__ unsigned xb_ld(unsigned* p)              { return __hip_atomic_load(p, __ATOMIC_RELAXED, __HIP_MEMORY_SCOPE_AGENT); }
__device__ __forceinline__ unsigned xb_add(unsigned* p, unsigned v) { return __hip_atomic_fetch_add(p, v, __ATOMIC_RELAXED, __HIP_MEMORY_SCOPE_AGENT); }
__device__ __forceinline__ unsigned xb_xcc_id() { return (unsigned)__builtin_amdgcn_s_getreg((3 << 11) | 20) & 0xFu; }
#define XB_SPIN(cond, bar) do { unsigned _sp = 0; while (cond) { __builtin_amdgcn_s_sleep(1); \
    if ((++_sp & 255u) == 0u) { if (xb_ld(&(bar)[XB_TMO])) break; if (_sp > XB_SPIN_CAP) { atomicAdd(&(bar)[XB_TMO], 1u); break; } } } } while (0)
struct XcdBarrier { unsigned* bar; unsigned x; volatile LAS unsigned* st; };
__device__ __forceinline__ XcdBarrier xcd_barrier_post(unsigned* bar, volatile LAS unsigned* st) {
    XcdBarrier b; b.bar = bar; b.x = xb_xcc_id(); b.st = st;
    if (threadIdx.x == 0) (void)xb_add(&bar[XB_XCNT(b.x)], 1u);
    return b;
}
__device__ __forceinline__ void xcd_barrier_complete(unsigned* bar, unsigned x, unsigned& nloc, unsigned& nx) {
    const unsigned G = gridDim.x * gridDim.y * gridDim.z;
    unsigned sum, cnt, mine, sp = 0u;
    for (;;) {
        sum = 0u; cnt = 0u; mine = 0u;
#pragma unroll
        for (unsigned j = 0; j < 16; ++j) { const unsigned c = xb_ld(&bar[XB_XCNT(j)]); sum += c; cnt += (c > 0u) ? 1u : 0u; mine = (j == x) ? c : mine; }
        if (sum == G) break;
        __builtin_amdgcn_s_sleep(1);
        if ((++sp & 255u) == 0u) { if (xb_ld(&bar[XB_TMO])) break; if (sp > XB_SPIN_CAP) { atomicAdd(&bar[XB_TMO], 1u); break; } }
    }
    nloc = mine > 0u ? mine : 1u; nx = cnt > 0u ? cnt : 1u;
}
__device__ __forceinline__ void xcd_barrier(const XcdBarrier& b) {
    asm volatile("s_waitcnt vmcnt(0)" ::: "memory");
    __syncthreads();
    if (threadIdx.x == 0) {
        unsigned* bar = b.bar;
        __builtin_amdgcn_s_waitcnt(0);
        unsigned nloc = b.st[0], nx = b.st[1];
        if (nloc == 0u) { xcd_barrier_complete(bar, b.x, nloc, nx); b.st[0] = nloc; b.st[1] = nx; }
        const unsigned old = xb_add(&bar[XB_XSUB(b.x)], 1u);
        const unsigned gen = old / nloc;
        if (old + 1u == (gen + 1u) * nloc) {
            __builtin_amdgcn_fence(__ATOMIC_RELEASE, "agent");
            asm volatile("s_waitcnt vmcnt(0)" ::: "memory");
            const unsigned og = xb_add(&bar[XB_TOP], 1u);
            const unsigned tg = og / nx;
            if (og + 1u == (tg + 1u) * nx) xb_add(&bar[XB_TOPGEN], 1u);
            else XB_SPIN(xb_ld(&bar[XB_TOPGEN]) == tg, bar);
            __builtin_amdgcn_fence(__ATOMIC_ACQUIRE, "agent");
            xb_add(&bar[XB_XGEN(b.x)], 1u);
            asm volatile("s_waitcnt vmcnt(0)" ::: "memory");
        } else {
            XB_SPIN(xb_ld(&bar[XB_XGEN(b.x)]) == gen, bar);
            __builtin_amdgcn_fence(__ATOMIC_ACQUIRE, "agent");
            asm volatile("s_waitcnt vmcnt(0)" ::: "memory");
        }
    }
    __syncthreads();
}

struct Args { const float* in[10]; float* out; unsigned char* ws; int ph_lo, ph_hi; };
__global__ void __launch_bounds__(512, 2) mk_fwd(Args args) {
    extern __shared__ __attribute__((aligned(16))) unsigned char lds_raw[];
    LAS unsigned char* lds = (LAS unsigned char*)lds_raw;
    cg::grid_group grid = cg::this_grid();
    const int tid = threadIdx.x, lane = tid & 63, wave = tid >> 6;
    const int G = gridDim.x, bid = blockIdx.x;
    unsigned char* ws = args.ws;
    const float* x = args.in[0]; const float* norm_g = args.in[1]; const float* w_in = args.in[2]; const float* b_gate = args.in[3];
    const float* lb_logits = args.in[4]; const float* hg_norm_g = args.in[5]; const float* w_sb = args.in[6]; const float* w_hg = args.in[7];
    const float* w_out = args.in[8]; const float* fng = args.in[9];
    float* out = args.out;
    bf16_t* Wt_in = (bf16_t*)(ws + WS_WIN); bf16_t* Wt_sbhg = (bf16_t*)(ws + WS_WSBHG); bf16_t* Wt_out = (bf16_t*)(ws + WS_WOUT);
    float* DG = (float*)(ws + WS_HGD);
    bf16_t* Hn = (bf16_t*)(ws + WS_H); bf16_t* SBQ = (bf16_t*)(ws + WS_SBQ); bf16_t* HGQ = (bf16_t*)(ws + WS_HGQ);
    bf16_t* SBK = (bf16_t*)(ws + WS_SBK); bf16_t* SBV = (bf16_t*)(ws + WS_SBV); bf16_t* HGI = (bf16_t*)(ws + WS_HGI);
    float* ST = (float*)(ws + WS_ST); bf16_t* GATES = (bf16_t*)(ws + WS_GATES); bf16_t* Y = (bf16_t*)(ws + WS_Y);
    float* Gf = out;
    const int lo = args.ph_lo, hi = args.ph_hi;
    if (lo < 0) grid.sync();
    if (tid < 16) ((LAS unsigned*)(lds + LDS_MISC))[tid] = 0u;
    __syncthreads();
    XcdBarrier bar = xcd_barrier_post((unsigned*)ws, (volatile LAS unsigned*)(lds + LDS_MISC));
#define IN(k) (lo <= (k) && (k) < hi)
#define SEAM(k) do { if (IN(k) && IN((k) + 1)) xcd_barrier(bar); } while (0)

    if (IN(0)) {
        LAS float* scr = (LAS float*)(lds + wave * 16384);
        const int gw = bid * 8 + wave, NGW = G * 8;
        for (int it = gw; it < 16 * 192; it += NGW) {
            const int kb = it / 192, j = it % 192, sg = j >> 5, seg = sg < 3 ? sg : sg + 1;
            p0_transpose_kn(w_in, 1024, 10240, Wt_in, 0, scr, kb, seg * 32 + (j & 31), lane);
        }
        for (int m4 = gw * 4; m4 < M_TOK; m4 += NGW * 4) {
            f32x4 v[4][4]; float s2[4];
#pragma unroll
            for (int q = 0; q < 4; ++q) { const f32x4* xr = (const f32x4*)(x + (size_t)(m4 + q) * 1024) + lane;
#pragma unroll
                for (int j = 0; j < 4; ++j) v[q][j] = xr[64 * j]; }
#pragma unroll
            for (int q = 0; q < 4; ++q) { s2[q] = 0.f;
#pragma unroll
                for (int j = 0; j < 4; ++j) s2[q] += (v[q][j][0] * v[q][j][0] + v[q][j][1] * v[q][j][1]) + (v[q][j][2] * v[q][j][2] + v[q][j][3] * v[q][j][3]); }
#pragma unroll
            for (int o = 1; o < 64; o <<= 1) {
#pragma unroll
                for (int q = 0; q < 4; ++q) s2[q] += __shfl_xor(s2[q], o); }
#pragma unroll
            for (int q = 0; q < 4; ++q) {
                const float rstd = __builtin_amdgcn_rsqf(s2[q] * (1.f / 1024.f) + RMS_EPS);
                u32x2* o8 = (u32x2*)(Hn + (size_t)(m4 + q) * 1024) + lane;
#pragma unroll
                for (int j = 0; j < 4; ++j) { const f32x4 gg = *((const f32x4*)norm_g + lane + 64 * j);
                    o8[64 * j] = (u32x2){pk2(v[q][j][0] * rstd * gg[0], v[q][j][1] * rstd * gg[1]), pk2(v[q][j][2] * rstd * gg[2], v[q][j][3] * rstd * gg[3])}; }
            }
        }
        __syncthreads();
    }
    SEAM(0);
    if (IN(1)) {
        pg8::Gemm g{Hn, Wt_in, M_TOK, 10240, 1024}; pg8::SegOrder S; S.init(G, bid, 0);
        EpiA E{SBQ, SBK, SBV, HGQ, HGI, Gf, lb_logits};
        pg8::gemm_phase<EpiA, pg8::SegOrder, true, true>(lds, g, S, E);
    }
    SEAM(1);
    const bool scan_in_p2 = (G == 256);
    unsigned* cntA = (unsigned*)(ws + 65536);
    unsigned* cntS = (unsigned*)(ws + 65536 + 4096);
    if (IN(2)) {
        for (int u = bid; u < 512; u += G) hg_unit_a(lds, u, Gf, HGI, ST, DG, scan_in_p2 ? cntA : nullptr);
        __syncthreads();
        for (int u = bid; u < 1024; u += G) sb_unit(lds, u, SBQ, SBK, SBV);
        __syncthreads();
        if (scan_in_p2) {
            grp_wait(cntA + 64 * (bid >> 5), 32u); grp_wait(cntA + 64 * ((bid >> 5) + 8), 32u);
#pragma unroll
            for (int j = 0; j < 2; ++j) {
                const int bh = (bid >> 5) + 8 * j;
                const int kv = (bid & 31) * 512 + tid, k = kv >> 7;
                float* stp = ST + ((size_t)(bh * 32) << 14) + kv;
                const float* dgp = DG + (bh * 32) * 128 + k;
                float u[32], d[32];
#pragma unroll
                for (int c = 0; c < 32; ++c) { u[c] = stp[(size_t)c << 14]; d[c] = dgp[c * 128]; }
                float S = 0.f;
#pragma unroll
                for (int c = 0; c < 32; ++c) { __hip_atomic_store(&stp[(size_t)c << 14], S, __ATOMIC_RELAXED, __HIP_MEMORY_SCOPE_AGENT); S = d[c] * S + u[c]; }
            }
            grp_arrive(cntS + 64 * (bid >> 5));
        }
    }
    if (!scan_in_p2) SEAM(2);
    if (IN(3) && !scan_in_p2) {
        for (int e = bid * 512 + tid; e < 16 * 16384; e += G * 512) {
            const int bh = e >> 14, kv = e & 16383, k = kv >> 7;
            float* stp = ST + ((size_t)(bh * 32) << 14) + kv;
            const float* dgp = DG + (bh * 32) * 128 + k;
            float u[32], d[32];
#pragma unroll
            for (int c = 0; c < 32; ++c) { u[c] = stp[(size_t)c << 14]; d[c] = dgp[c * 128]; }
            float S = 0.f;
#pragma unroll
            for (int c = 0; c < 32; ++c) { stp[(size_t)c << 14] = S; S = d[c] * S + u[c]; }
        }
    }
    if (IN(3) && IN(4) && !scan_in_p2) xcd_barrier(bar);
    if (IN(4)) {
        {
            LAS float* scr = (LAS float*)(lds + wave * 16384);
            const int gw = bid * 8 + wave, NGW = G * 8;
            for (int it = gw; it < 16 * 128 + 3 * 512; it += NGW) {
                int r = it;
                if (r < 16 * 128) { const int kb = r / 128, j = r % 128, sg = j >> 5, seg = sg == 0 ? 3 : sg + 6; p0_transpose_kn(w_in, 1024, 10240, Wt_in, 0, scr, kb, seg * 32 + (j & 31), lane); continue; } r -= 16 * 128;
                if (r < 512) { p0_transpose_kn(w_sb, 1024, 1024, Wt_sbhg, 0, scr, r / 32, r % 32, lane); continue; } r -= 512;
                if (r < 512) { p0_transpose_kn(w_hg, 1024, 1024, Wt_sbhg, 1024, scr, r / 32, r % 32, lane); continue; } r -= 512;
                p0_transpose_kn(w_out, 1024, 1024, Wt_out, 0, scr, r / 32, r % 32, lane);
            }
            __syncthreads();
        }
        if (scan_in_p2) grp_wait(cntS + 64 * (bid >> 5), 32u);
        for (int u = bid; u < 512; u += G) hg_unit_c(lds, u, Gf, HGQ, HGI, ST, hg_norm_g);
        __syncthreads();
    }
    SEAM(4);
    if (IN(5)) {
        pg8::Gemm g{Hn, Wt_in, M_TOK, 10240, 1024}; pg8::SegOrder S; S.init(G, bid, 1);
        EpiB E{SBQ, HGQ, GATES, b_gate};
        pg8::gemm_phase<EpiB, pg8::SegOrder, true, true>(lds, g, S, E);
    }
    SEAM(5);
    if (IN(6)) {
        pg8::Gemm g{SBQ, Wt_sbhg, 2 * M_TOK, 2048, 1024}; pg8::PairOrder S; S.init(G, bid);
        EpiC E{GATES, out, Y};
        pg8::gemm_phase<EpiC, pg8::PairOrder, true, true>(lds, g, S, E);
    }
    SEAM(6);
    if (IN(7)) {
        pg8::Gemm g{Y, Wt_out, M_TOK, 1024, 1024}; pg8::PlainOrder S; S.init(M_TOK, 1024, G, bid);
        EpiD E{x, out, fng, (float*)(ws + 131072), (unsigned*)(ws + 16384)};
        pg8::gemm_phase<EpiD, pg8::PlainOrder, true, true>(lds, g, S, E);
    }
#undef IN
#undef SEAM
}

#ifndef MK_N_LAUNCHES
#define MK_N_LAUNCHES 1
#endif
extern "C" void kernel_launch(void* const* d_in, const int* in_sizes, int n_in, void* d_out, int out_size, void* d_ws, size_t ws_size, hipStream_t stream) {
    static int grid = 0;
    if (grid == 0) {
        if (n_in != 10 || out_size != M_TOK * DM || ws_size < WS_END) { fprintf(stderr, "kernel_launch: unexpected shapes (n_in %d out %d ws %zu)\n", n_in, out_size, ws_size); grid = -1; return; }
        int dev = 0, cus = 0, per_cu = 0;
        (void)hipGetDevice(&dev);
        (void)hipDeviceGetAttribute(&cus, hipDeviceAttributeMultiprocessorCount, dev);
        if (hipFuncSetAttribute((const void*)mk_fwd, hipFuncAttributeMaxDynamicSharedMemorySize, LDS_BYTES) != hipSuccess) { fprintf(stderr, "kernel_launch: hipFuncSetAttribute failed\n"); grid = -1; return; }
        if (hipOccupancyMaxActiveBlocksPerMultiprocessor(&per_cu, (const void*)mk_fwd, 512, LDS_BYTES) != hipSuccess || per_cu < 1) { fprintf(stderr, "kernel_launch: occupancy query says %d\n", per_cu); per_cu = 1; }
        (void)hipGetLastError();
        grid = cus > 0 ? cus : 256;
    }
    if (grid < 0) return;
    if (hipMemsetAsync(d_ws, 0, 65536 + 8192, stream) != hipSuccess) { fprintf(stderr, "kernel_launch: memset failed\n"); return; }
    Args a{};
    for (int i = 0; i < 10; ++i) a.in[i] = (const float*)d_in[i];
    a.out = (float*)d_out; a.ws = (unsigned char*)d_ws;
#if MK_N_LAUNCHES == 1
    a.ph_lo = 0; a.ph_hi = 8;
    void* kargs[] = {&a};
    hipError_t e = hipLaunchCooperativeKernel((const void*)mk_fwd, dim3(grid), dim3(512), kargs, LDS_BYTES, stream);
    if (e != hipSuccess) fprintf(stderr, "kernel_launch: cooperative launch failed: %s (grid %d)\n", hipGetErrorString(e), grid);
#else
    for (int p = 0; p < 8; ++p) { a.ph_lo = p; a.ph_hi = p + 1; hipLaunchKernelGGL(mk_fwd, dim3(grid), dim3(512), LDS_BYTES, stream, a); }
#endif
}
```
